# Optimizing an MI355X kernel written in HIP

```python
import math, functools
import jax, jax.numpy as jnp
from jax import lax
import numpy as np

D_MODEL = 1024
BATCH = 16
SEQ = 256
DEPTH = 4
DEC_BATCH = 8
DEC_SEQ = 4096
PAST_LEN = 512

GRID_W = 64
N_MIXERS = 2
N_ATTN_LAYERS = (DEPTH + 1) // 2
N_SSM_LAYERS = DEPTH // 2
N_HEADS = 16
N_KV_HEADS = 4
HEAD_DIM = 64
Q_WIDTH = N_HEADS * HEAD_DIM
KV_WIDTH = N_KV_HEADS * HEAD_DIM
WINDOW = 128
BLOCK = 128
ROPE_BASE = 10000.0
SSM_WIDTH = D_MODEL
SSM_GROUP = 16
N_GROUPS = SSM_WIDTH // SSM_GROUP
STATE = 64
SSM_CHUNK = 128
D_FF = -(-8 * D_MODEL // (3 * 256)) * 256
DN_ALPHA = (2 * DEPTH) ** 0.25
DN_BETA = (8 * DEPTH) ** -0.25
LN_EPS = 1e-5
NEG_INF = -1e30

kernel_name = "hybrid_swa_s5_diffusion_step"


def layer_norm(x, g, b):
    xf = x.astype(jnp.float32)
    mu = jnp.mean(xf, -1, keepdims=True)
    var = jnp.mean(jnp.square(xf - mu), -1, keepdims=True)
    return ((xf - mu) * lax.rsqrt(var + LN_EPS) * g + b).astype(x.dtype)


def ada_params(cvec, w, b):
    m = (jax.nn.silu(cvec) @ w + b).reshape(cvec.shape[0], 6, 1, D_MODEL)
    return [m[:, i] for i in range(6)]


def modulate(x, shift, scale):
    return x * (1 + scale) + shift


def swiglu(h, w1, w3, w2):
    return (jax.nn.silu(h @ w1) * (h @ w3)) @ w2


def trunk_layer(x, mods, mixer, ln_g, ln_b, w1, w3, w2):
    sh1, sc1, g1, sh2, sc2, g2 = mods
    out, extra = mixer(modulate(x, sh1, sc1))
    x = layer_norm(DN_ALPHA * x + g1 * out, ln_g[0], ln_b[0])
    x = layer_norm(DN_ALPHA * x + g2 * swiglu(modulate(x, sh2, sc2), w1, w3, w2), ln_g[1], ln_b[1])
    return x, extra


def split_qkv(h, w):
    n, t, _ = h.shape
    qkv = h @ w
    q = qkv[..., :Q_WIDTH].reshape(n, t, N_HEADS, HEAD_DIM)
    k = qkv[..., Q_WIDTH:Q_WIDTH + KV_WIDTH].reshape(n, t, N_KV_HEADS, HEAD_DIM)
    v = qkv[..., Q_WIDTH + KV_WIDTH:].reshape(n, t, N_KV_HEADS, HEAD_DIM)
    return q, k, v


def sink_softmax(s, sink):
    m = jnp.maximum(jnp.max(s, -1, keepdims=True), sink)
    p = jnp.exp(s - m)
    return p / (jnp.sum(p, -1, keepdims=True) + jnp.exp(sink - m))


def axial_rope_angles(t):
    n_rows = t // GRID_W
    row = jnp.repeat(jnp.arange(n_rows, dtype=jnp.float32), GRID_W)
    col = (jnp.arange(t) % GRID_W).astype(jnp.float32)
    nfreq = HEAD_DIM // 4
    inv = jnp.power(ROPE_BASE, -jnp.arange(nfreq, dtype=jnp.float32) / nfreq)
    return row[:, None] * inv, col[:, None] * inv


def rotate_half(x, ang):
    x1, x2 = jnp.split(x, 2, -1)
    c = jnp.cos(ang)[None, :, None, :].astype(x.dtype)
    s = jnp.sin(ang)[None, :, None, :].astype(x.dtype)
    return jnp.concatenate([x1 * c - x2 * s, x1 * s + x2 * c], -1)


def apply_axial_rope(x, ang_row, ang_col):
    xr, xc = jnp.split(x, 2, -1)
    return jnp.concatenate([rotate_half(xr, ang_row), rotate_half(xc, ang_col)], -1)


def context_attention(q, k, v, sink):
    n, L = q.shape[:2]
    g = N_HEADS // N_KV_HEADS
    qb = q.reshape(n, L // BLOCK, BLOCK, N_KV_HEADS, g, HEAD_DIM).swapaxes(0, 1)
    sink_b = sink.astype(jnp.float32).reshape(1, N_KV_HEADS, g, 1, 1)
    scale = HEAD_DIM ** -0.5

    def one_block(qj):
        s = jnp.einsum('nqkgd,nskd->nkgqs', qj, k, preferred_element_type=jnp.float32) * scale
        p = sink_softmax(s, sink_b).astype(v.dtype)
        return jnp.einsum('nkgqs,nskd->nqkgd', p, v)

    o = lax.map(one_block, qb)
    return o.swapaxes(0, 1).reshape(n, L, Q_WIDTH)


def latent_attention(q_rot, q_plain, k_rot, v, k_ctx, v_ctx, sink):
    n, t = q_rot.shape[:2]
    g = N_HEADS // N_KV_HEADS
    L = k_ctx.shape[1]
    kp = jnp.pad(k_rot, ((0, 0), (BLOCK, BLOCK), (0, 0), (0, 0)))
    vp = jnp.pad(v, ((0, 0), (BLOCK, BLOCK), (0, 0), (0, 0)))
    sink_b = sink.astype(jnp.float32).reshape(1, N_KV_HEADS, g, 1, 1)
    scale = HEAD_DIM ** -0.5
    q_offs = jnp.arange(BLOCK)
    k_offs = jnp.arange(3 * BLOCK) - BLOCK

    def one_block(j):
        start = j * BLOCK
        qr = lax.dynamic_slice_in_dim(q_rot, start, BLOCK, axis=1).reshape(n, BLOCK, N_KV_HEADS, g, HEAD_DIM)
        qp = lax.dynamic_slice_in_dim(q_plain, start, BLOCK, axis=1).reshape(n, BLOCK, N_KV_HEADS, g, HEAD_DIM)
        kj = lax.dynamic_slice_in_dim(kp, start, 3 * BLOCK, axis=1)
        vj = lax.dynamic_slice_in_dim(vp, start, 3 * BLOCK, axis=1)
        qpos = start + q_offs
        kpos = start + k_offs
        valid = (kpos[None, :] >= 0) & (kpos[None, :] < t) & (jnp.abs(qpos[:, None] - kpos[None, :]) <= WINDOW)
        s_loc = jnp.einsum('nqkgd,nskd->nkgqs', qr, kj, preferred_element_type=jnp.float32) * scale
        s_loc = jnp.where(valid, s_loc, NEG_INF)
        s_ctx = jnp.einsum('nqkgd,nskd->nkgqs', qp, k_ctx, preferred_element_type=jnp.float32) * scale
        p = sink_softmax(jnp.concatenate([s_ctx, s_loc], -1), sink_b).astype(v.dtype)
        return (jnp.einsum('nkgqs,nskd->nqkgd', p[..., :L], v_ctx)
                + jnp.einsum('nkgqs,nskd->nqkgd', p[..., L:], vj))

    o = lax.map(one_block, jnp.arange(t // BLOCK))
    return o.swapaxes(0, 1).reshape(n, t, Q_WIDTH)


def ctx_attn_mixer(h, w_qkv_a, w_o_a, sink_a):
    q, k, v = split_qkv(h, w_qkv_a)
    return context_attention(q, k, v, sink_a) @ w_o_a, (k, v)


def lat_attn_mixer(h, k_ctx, v_ctx, ang_row, ang_col, w_qkv_a, w_o_a, sink_a):
    q, k, v = split_qkv(h, w_qkv_a)
    o = latent_attention(apply_axial_rope(q, ang_row, ang_col), q,
                         apply_axial_rope(k, ang_row, ang_col), v, k_ctx, v_ctx, sink_a)
    return o @ w_o_a, None


def s5_discretise(lam_re, lam_im, log_dt, b_re, b_im):
    lam_re = lam_re.astype(jnp.float32)
    lam_im = lam_im.astype(jnp.float32)
    dt = jnp.exp(log_dt.astype(jnp.float32))[:, None]
    mag = jnp.exp(lam_re * dt)
    a_re = mag * jnp.cos(lam_im * dt)
    a_im = mag * jnp.sin(lam_im * dt)
    den = lam_re ** 2 + lam_im ** 2
    nr, ni = a_re - 1.0, a_im
    coef_re = ((nr * lam_re + ni * lam_im) / den)[..., None]
    coef_im = ((ni * lam_re - nr * lam_im) / den)[..., None]
    b_re = b_re.astype(jnp.float32)
    b_im = b_im.astype(jnp.float32)
    bb_re = coef_re * b_re - coef_im * b_im
    bb_im = coef_re * b_im + coef_im * b_re
    return a_re, a_im, bb_re, bb_im


def complex_linear_combine(e1, e2):
    a1r, a1i, b1r, b1i = e1
    a2r, a2i, b2r, b2i = e2
    return (a2r * a1r - a2i * a1i, a2r * a1i + a2i * a1r,
            a2r * b1r - a2i * b1i + b2r, a2r * b1i + a2i * b1r + b2i)


def s5_direction(u, h0_re, h0_im, lam_re, lam_im, log_dt, b_re, b_im, c_re, c_im, reverse):
    a_re, a_im, bb_re, bb_im = s5_discretise(lam_re, lam_im, log_dt, b_re, b_im)
    c_re = c_re.astype(jnp.float32)
    c_im = c_im.astype(jnp.float32)
    n, t = u.shape[:2]
    if reverse:
        u = jnp.flip(u, 1)
    uc = u.reshape(n, t // SSM_CHUNK, SSM_CHUNK, N_GROUPS, SSM_GROUP).swapaxes(0, 1)
    a_r = jnp.broadcast_to(a_re[None, None], (SSM_CHUNK, 1, N_GROUPS, STATE))
    a_i = jnp.broadcast_to(a_im[None, None], (SSM_CHUNK, 1, N_GROUPS, STATE))

    def chunk(carry, u_blk):
        hr, hi = carry
        bu_r = jnp.einsum('ncgm,gpm->cngp', u_blk, bb_re)
        bu_i = jnp.einsum('ncgm,gpm->cngp', u_blk, bb_im)
        bu_r = bu_r.at[0].add(a_re * hr - a_im * hi)
        bu_i = bu_i.at[0].add(a_re * hi + a_im * hr)
        _, _, sr, si = lax.associative_scan(complex_linear_combine, (a_r, a_i, bu_r, bu_i), axis=0)
        y = jnp.einsum('cngp,gmp->ncgm', sr, c_re) - jnp.einsum('cngp,gmp->ncgm', si, c_im)
        return (sr[-1], si[-1]), y

    (hr, hi), ys = lax.scan(chunk, (h0_re.astype(jnp.float32), h0_im.astype(jnp.float32)), uc)
    y = ys.swapaxes(0, 1).reshape(n, t, N_GROUPS, SSM_GROUP)
    if reverse:
        y = jnp.flip(y, 1)
    return y, hr, hi


def s5_mixer(h, h0_re, h0_im, w_in, lam_re, lam_im, log_dt, b_re, b_im, c_re, c_im, d_skip, w_glu, w_out):
    n, t, _ = h.shape
    u = (h @ w_in).astype(jnp.float32).reshape(n, t, N_GROUPS, SSM_GROUP)
    y_f, hfr, hfi = s5_direction(u, h0_re[:, 0], h0_im[:, 0], lam_re[0], lam_im[0], log_dt[0],
                                 b_re[0], b_im[0], c_re[0], c_im[0], False)
    y_b, hbr, hbi = s5_direction(u, h0_re[:, 1], h0_im[:, 1], lam_re[1], lam_im[1], log_dt[1],
                                 b_re[1], b_im[1], c_re[1], c_im[1], True)
    y = y_f + y_b + d_skip.astype(jnp.float32).reshape(N_GROUPS, SSM_GROUP) * u
    y = jax.nn.gelu(y.reshape(n, t, SSM_WIDTH)).astype(h.dtype)
    val, gate = jnp.split(y @ w_glu, 2, -1)
    out = (val * jax.nn.sigmoid(gate)) @ w_out
    return out, (jnp.stack([hfr, hbr], 1), jnp.stack([hfi, hbi], 1))


def setup_inputs(seed: int = 0) -> dict:
    key = jax.random.key(seed)
    ks = jax.random.split(key, 32)
    f32 = jnp.float32

    def nrm(k, shape, std):
        return std * jax.random.normal(k, shape, f32)

    n_idx = jnp.arange(STATE, dtype=f32)
    lam_shape = (N_SSM_LAYERS, 2, N_GROUPS, STATE)
    return {
        "x_prompt": nrm(ks[0], (BATCH, SEQ, D_MODEL), 1.0),
        "x_sample": nrm(ks[1], (DEC_BATCH, DEC_SEQ, D_MODEL), 1.0),
        "cache_k": nrm(ks[2], (DEC_BATCH, N_ATTN_LAYERS, PAST_LEN, N_KV_HEADS, HEAD_DIM), 1.0),
        "cache_v": nrm(ks[3], (DEC_BATCH, N_ATTN_LAYERS, PAST_LEN, N_KV_HEADS, HEAD_DIM), 1.0),
        "state_ssm_re": nrm(ks[4], (DEC_BATCH, N_SSM_LAYERS, 2, N_GROUPS, STATE), 0.3),
        "state_ssm_im": nrm(ks[5], (DEC_BATCH, N_SSM_LAYERS, 2, N_GROUPS, STATE), 0.3),
        "c": nrm(ks[6], (DEC_BATCH, D_MODEL), 1.0),
        "c_ctx": nrm(ks[7], (D_MODEL,), 1.0),
        "w_ada": nrm(ks[8], (DEPTH, D_MODEL, 6 * D_MODEL), 0.5 * D_MODEL ** -0.5),
        "b_ada": nrm(ks[9], (DEPTH, 6 * D_MODEL), 0.02),
        "ln_g": 1.0 + nrm(ks[10], (DEPTH, 2, D_MODEL), 0.02),
        "ln_b": nrm(ks[11], (DEPTH, 2, D_MODEL), 0.02),
        "w_qkv": nrm(ks[12], (N_ATTN_LAYERS, D_MODEL, Q_WIDTH + 2 * KV_WIDTH), D_MODEL ** -0.5),
        "w_o": nrm(ks[13], (N_ATTN_LAYERS, Q_WIDTH, D_MODEL), DN_BETA * Q_WIDTH ** -0.5),
        "attn_sink": nrm(ks[14], (N_ATTN_LAYERS, N_HEADS), 0.5),
        "ssm_w_in": nrm(ks[15], (N_SSM_LAYERS, D_MODEL, SSM_WIDTH), D_MODEL ** -0.5),
        "ssm_lam_re": -0.5 + nrm(ks[16], lam_shape, 0.01),
        "ssm_lam_im": math.pi * n_idx + nrm(ks[17], lam_shape, 0.01),
        "ssm_log_dt": jax.random.uniform(ks[18], (N_SSM_LAYERS, 2, N_GROUPS), f32,
                                         minval=math.log(1e-3), maxval=math.log(1e-1)),
        "ssm_b_re": nrm(ks[19], (N_SSM_LAYERS, 2, N_GROUPS, STATE, SSM_GROUP), (2 * SSM_GROUP) ** -0.5),
        "ssm_b_im": nrm(ks[20], (N_SSM_LAYERS, 2, N_GROUPS, STATE, SSM_GROUP), (2 * SSM_GROUP) ** -0.5),
        "ssm_c_re": nrm(ks[21], (N_SSM_LAYERS, 2, N_GROUPS, SSM_GROUP, STATE), STATE ** -0.5),
        "ssm_c_im": nrm(ks[22], (N_SSM_LAYERS, 2, N_GROUPS, SSM_GROUP, STATE), STATE ** -0.5),
        "ssm_d": nrm(ks[23], (N_SSM_LAYERS, SSM_WIDTH), 1.0),
        "ssm_w_glu": nrm(ks[24], (N_SSM_LAYERS, SSM_WIDTH, 2 * SSM_WIDTH), SSM_WIDTH ** -0.5),
        "ssm_w_out": nrm(ks[25], (N_SSM_LAYERS, SSM_WIDTH, D_MODEL), DN_BETA * SSM_WIDTH ** -0.5),
        "ffn_w1": nrm(ks[26], (DEPTH, D_MODEL, D_FF), D_MODEL ** -0.5),
        "ffn_w3": nrm(ks[27], (DEPTH, D_MODEL, D_FF), D_MODEL ** -0.5),
        "ffn_w2": nrm(ks[28], (DEPTH, D_FF, D_MODEL), DN_BETA * D_FF ** -0.5),
    }


def reference(x_prompt, x_sample, cache_k, cache_v, state_ssm_re, state_ssm_im, c, c_ctx,
              w_ada, b_ada, ln_g, ln_b, w_qkv, w_o, attn_sink,
              ssm_w_in, ssm_lam_re, ssm_lam_im, ssm_log_dt, ssm_b_re, ssm_b_im,
              ssm_c_re, ssm_c_im, ssm_d, ssm_w_glu, ssm_w_out,
              ffn_w1, ffn_w3, ffn_w2):
    def ssm_params(s):
        return (ssm_w_in[s], ssm_lam_re[s], ssm_lam_im[s], ssm_log_dt[s], ssm_b_re[s], ssm_b_im[s],
                ssm_c_re[s], ssm_c_im[s], ssm_d[s], ssm_w_glu[s], ssm_w_out[s])

    y = x_prompt
    zeros_state = jnp.zeros((x_prompt.shape[0], 2, N_GROUPS, STATE), jnp.float32)
    new_k, new_v, new_sr, new_si = [], [], [], []
    for l in range(DEPTH):
        mods = ada_params(c_ctx[None, :], w_ada[l], b_ada[l])
        if l % N_MIXERS == 0:
            a = l // N_MIXERS
            mixer = functools.partial(ctx_attn_mixer, w_qkv_a=w_qkv[a], w_o_a=w_o[a], sink_a=attn_sink[a])
        else:
            s = l // N_MIXERS
            mixer = functools.partial(s5_mixer, h0_re=zeros_state, h0_im=zeros_state,
                                      **dict(zip(('w_in', 'lam_re', 'lam_im', 'log_dt', 'b_re', 'b_im',
                                                  'c_re', 'c_im', 'd_skip', 'w_glu', 'w_out'), ssm_params(s))))
        y, extra = trunk_layer(y, mods, mixer, ln_g[l], ln_b[l], ffn_w1[l], ffn_w3[l], ffn_w2[l])
        if l % N_MIXERS == 0:
            new_k.append(extra[0])
            new_v.append(extra[1])
        else:
            new_sr.append(extra[0])
            new_si.append(extra[1])
    y_prompt = y

    z = x_sample
    ang_row, ang_col = axial_rope_angles(x_sample.shape[1])
    for l in range(DEPTH):
        mods = ada_params(c, w_ada[l], b_ada[l])
        if l % N_MIXERS == 0:
            a = l // N_MIXERS
            mixer = functools.partial(lat_attn_mixer, k_ctx=cache_k[:, a], v_ctx=cache_v[:, a],
                                      ang_row=ang_row, ang_col=ang_col,
                                      w_qkv_a=w_qkv[a], w_o_a=w_o[a], sink_a=attn_sink[a])
        else:
            s = l // N_MIXERS
            mixer = functools.partial(s5_mixer, h0_re=state_ssm_re[:, s], h0_im=state_ssm_im[:, s],
                                      **dict(zip(('w_in', 'lam_re', 'lam_im', 'log_dt', 'b_re', 'b_im',
                                                  'c_re', 'c_im', 'd_skip', 'w_glu', 'w_out'), ssm_params(s))))
        z, _ = trunk_layer(z, mods, mixer, ln_g[l], ln_b[l], ffn_w1[l], ffn_w3[l], ffn_w2[l])
    y_sample = z

    new_cache_k = jnp.stack(new_k, axis=1)
    new_cache_v = jnp.stack(new_v, axis=1)
    new_state_re = jnp.stack(new_sr, axis=1)
    new_state_im = jnp.stack(new_si, axis=1)
    return (y_prompt, y_sample, new_cache_k, new_cache_v, new_state_re, new_state_im)
```

```cpp
#include <hip/hip_runtime.h>
#include <hip/hip_bf16.h>
#include <hip/hip_cooperative_groups.h>
#include <cstdio>
namespace cg = cooperative_groups;

#ifndef ONE_LAUNCH
#define ONE_LAUNCH 0
#endif

typedef unsigned short u16;
using bf16x8 = __attribute__((ext_vector_type(8))) short;
using f32x4  = __attribute__((ext_vector_type(4))) float;
using f32x16 = __attribute__((ext_vector_type(16))) float;
#define DI __device__ __forceinline__
#define UNR _Pragma("unroll")

constexpr int D = 1024, DFF = 2816, MCTX = 4096, MLAT = 32768, MTOK = 36864;
constexpr int NCHR = 2304;
constexpr float DN_ALPHA = 1.681792830507429f;
constexpr float LN_EPS = 1e-5f;

constexpr long OUT_CK = 37748736L, OUT_CV = 39845888L, OUT_SR = 41943040L, OUT_SI = 42205184L;

constexpr size_t OFF_MODS = 0;
constexpr size_t OFF_ROPE = 1048576;
constexpr size_t OFF_KC   = OFF_ROPE + 65536;
constexpr size_t OFF_VTC  = OFF_KC + 4194304;
constexpr size_t OFF_X    = OFF_VTC + 4194304;
constexpr size_t OFF_H    = OFF_X + (size_t)MTOK * 4096;
constexpr size_t OFF_WA   = OFF_H + (size_t)MTOK * 2048;
constexpr size_t OFF_WB   = OFF_WA + 4194304;
constexpr size_t OFF_WGLU = OFF_WB + 2097152;
constexpr size_t OFF_W13  = OFF_WGLU + 4194304;
constexpr size_t OFF_W2   = OFF_W13 + 11534336;
constexpr size_t OFF_PT   = OFF_W2 + 5767168;
constexpr size_t OFF_TT   = OFF_PT + 8388608;
constexpr size_t OFF_R1   = OFF_TT + 16777216;
constexpr size_t R1_Q = 0, R1_KB = (size_t)MTOK * 2048, R1_VT = (size_t)MTOK * 2560, R1_O = (size_t)MTOK * 3072;
constexpr size_t R1_U = 0, R1_S = (size_t)MTOK * 2048, R1_GL = (size_t)MTOK * 2048;
constexpr size_t WS_TOTAL = OFF_R1 + (size_t)MTOK * 6144;

struct Params {
  const float *x_prompt, *x_sample, *cache_k, *cache_v, *st_re, *st_im, *c, *c_ctx, *w_ada, *b_ada, *ln_g, *ln_b,
      *w_qkv, *w_o, *sink, *ssm_w_in, *lam_re, *lam_im, *log_dt, *b_re, *b_im, *c_re, *c_im, *ssm_d, *w_glu, *w_out,
      *w1, *w3, *w2;
  float* out;
  char* ws;
};

DI int opaque_tid() {
  int w = __builtin_amdgcn_readfirstlane((int)threadIdx.x >> 6);
  int l = __builtin_amdgcn_mbcnt_hi(~0u, __builtin_amdgcn_mbcnt_lo(~0u, 0u));
  int t = (w << 6) | l; asm volatile("" : "+v"(t)); return t;
}
DI u16 f2bf(float f) { unsigned u = __float_as_uint(f); u += 0x7fffu + ((u >> 16) & 1u); return (u16)(u >> 16); }
DI float bf2f(u16 h) { return __uint_as_float(((unsigned)h) << 16); }
DI unsigned pack2(float a, float b) { return (unsigned)f2bf(a) | ((unsigned)f2bf(b) << 16); }
DI float wave_sum(float v) {
#pragma unroll
  for (int o = 32; o > 0; o >>= 1) v += __shfl_xor(v, o);
  return v;
}
DI int cond_of_row(int row) { return row < MCTX ? 0 : 1 + ((row - MCTX) >> 12); }
DI const float* mods_ptr(const Params& p, int l, int cond, int idx) {
  return (const float*)(p.ws + OFF_MODS) + ((size_t)((l * 9 + cond) * 6 + idx)) * 1024;
}
DI float fast_sigmoid(float x) { return 1.f / (1.f + __expf(-x)); }
DI float gelu_tanh(float x) { float u = 0.7978845608028654f * (x + 0.044715f * x * x * x); return x * fast_sigmoid(2.f * u); }

constexpr int BM = 256, BK = 64, HALF = 128, HT = HALF * BK, SHM_B = 8 * HT * 2;

DI int lds_byte(int r, int c) {
  int st = (r >> 4) * 2 + (c >> 5), rr = r & 15, cc = c & 31, ob = rr * 64 + cc * 2;
  return st * 1024 + (ob ^ (((ob >> 9) & 1) << 5));
}
DI void stage_rc(int b, int& R, int& C) {
  int st = b / 1024, sb = b % 1024, swz = sb ^ (((sb >> 9) & 1) << 5);
  R = (st >> 1) * 16 + swz / 64; C = (st & 1) * 32 + (swz % 64) / 2;
}

enum { EPI_QKV = 0, EPI_RES = 1, EPI_GATED = 2, EPI_PLAIN = 3, EPI_S = 4, EPI_Y = 5 };

struct GemmArgs {
  const u16* A;
  const u16* A2;
  const u16* Bt;
  int lda, K, nM, nN;
  int layer;
  int gidx;
  int act;
  int ldo;
  int attn_a;
  u16* o16;
  float* o32;
};

template <int AMODE, int EPI>
DI void gemm_phase(const Params& p, const GemmArgs& ga) {
  extern __shared__ __attribute__((aligned(16))) __hip_bfloat16 shm[];
#define SA(b, h) (shm + ((b) * 2 + (h)) * HT)
#define SB(b, h) (shm + (4 + (b) * 2 + (h)) * HT)
#define GLDS(src, dst) __builtin_amdgcn_global_load_lds((const unsigned*)(src), (unsigned*)(dst), 16, 0, 0)
#define STA(P, h, kt) do { const char* _s = (const char*)a_base(h, kt); unsigned _o; long _sk; if (AMODE == 2 && (kt) >= 4) { _o = offA2; _sk = skipA2; } else { _o = offA; _sk = skipA; } \
    GLDS(_s + (size_t)_o, (char*)(P) + tidx * 16); GLDS(_s + _sk + (size_t)_o, (char*)(P) + tidx * 16 + 8192); } while (0)
#define STB(P, h, kt) do { const char* _s = (const char*)(Bt + (long)(bcol + (h) * HALF) * K + (long)(kt) * BK); \
    GLDS(_s + (size_t)offB, (char*)(P) + tidx * 16); GLDS(_s + skipB + (size_t)offB, (char*)(P) + tidx * 16 + 8192); } while (0)
#define LDA(dst, b, h) UNR for (int m = 0; m < 4; ++m) UNR for (int k = 0; k < 2; ++k) \
    dst[m][k] = *reinterpret_cast<const bf16x8*>((char*)SA(b, h) + lds_byte(wr * 64 + m * 16 + fr, k * 32 + fq * 8))
#define LDB(dst, b, h) UNR for (int n = 0; n < 2; ++n) UNR for (int k = 0; k < 2; ++k) \
    dst[n][k] = *reinterpret_cast<const bf16x8*>((char*)SB(b, h) + lds_byte(wc * 32 + n * 16 + fr, k * 32 + fq * 8))
#define MMA(ai, bj, Af, Bf) do { __builtin_amdgcn_s_setprio(1); \
    UNR for (int m = 0; m < 4; ++m) UNR for (int n = 0; n < 2; ++n) UNR for (int k = 0; k < 2; ++k) \
      acc[ai][bj][m][n] = __builtin_amdgcn_mfma_f32_16x16x32_bf16(Bf[n][k], Af[m][k], acc[ai][bj][m][n], 0, 0, 0); \
    __builtin_amdgcn_s_setprio(0); } while (0)
#define WAIT_V(n) asm volatile("s_waitcnt vmcnt(" #n ")" ::: "memory")
#define WAIT_L(n) asm volatile("s_waitcnt lgkmcnt(" #n ")" ::: "memory")
#define BAR __builtin_amdgcn_s_barrier()
#define SCHED __builtin_amdgcn_sched_barrier(0)

  const int K = ga.K, nM = ga.nM, nN = ga.nN;
  const int ntiles = (AMODE == 0) ? nM * nN : 9 * 64;
  const int tidx = opaque_tid();
  const int wid = tidx >> 6, lane = tidx & 63, wr = wid >> 2, wc = wid & 3, fr = lane & 15, fq = lane >> 4;
  unsigned offA, offA2 = 0, offB;
  {
    int R0, C0;
    stage_rc(tidx * 16, R0, C0);
    if (AMODE == 0) offA = (R0 * ga.lda + C0) * 2;
    else { offA = ((R0 * 16 + (C0 >> 4)) * 1024 + (C0 & 15)) * 2; offA2 = (R0 * 16384 + C0) * 2; }
    offB = (R0 * K + C0) * 2;
  }
  const long skipA = AMODE == 0 ? (long)ga.lda * 128 : 64L * 16 * 1024 * 2, skipA2 = 64L * 16384 * 2, skipB = (long)K * 128;
  const int nt = K / BK;
  int vb = blockIdx.x;
  if ((gridDim.x & 7) == 0) vb = (blockIdx.x & 7) * (gridDim.x >> 3) + (blockIdx.x >> 3);

  for (int tile = vb; tile < ntiles; tile += gridDim.x) {
    int pm, pn, grp = 0;
    if (AMODE == 0) {
      const int WGM = 8;
      int nig = WGM * nN, gid = tile / nig, fm = gid * WGM, gsz = min(nM - fm, WGM);
      pm = fm + ((tile % nig) % gsz); pn = (tile % nig) / gsz;
    } else { grp = tile / 9; pm = tile % 9; pn = 0; }
    const int brow = pm * BM, bcol = pn * BM;
    const u16* Bt = ga.Bt + (AMODE == 0 ? 0L : (long)grp * 256 * K);
    auto a_base = [&](int h, int kt) -> const u16* {
      if (AMODE == 0) return ga.A + (long)(brow + h * HALF) * ga.lda + (long)kt * BK;
      if (AMODE == 2 && kt >= 4) return ga.A2 + (long)(brow + h * HALF) * 16384 + grp * 256 + (kt - 4) * BK;
      return ga.A + ((long)(brow + h * HALF) * 16 + kt * 4) * 1024 + grp * 16;
    };

    f32x4 acc[2][2][4][2] = {};
    bf16x8 At[4][2], B0[2][2], B1[2][2];
    STB(SB(0, 0), 0, 0); STA(SA(0, 0), 0, 0);
    STB(SB(0, 1), 1, 0); STA(SA(0, 1), 1, 0);
    if (wr == 1) BAR;
    WAIT_V(4); BAR;
    STB(SB(1, 0), 0, 1); STA(SA(1, 0), 0, 1); STB(SB(1, 1), 1, 1);
    WAIT_V(6); BAR;
    for (int t = 0; t < nt - 2; t += 2) {
      LDB(B0, 0, 0); SCHED; LDA(At, 0, 0); STA(SA(1, 1), 1, t + 1);
      WAIT_L(8); BAR; WAIT_L(0); MMA(0, 0, At, B0); BAR; SCHED;
      LDB(B1, 0, 1); STB(SB(0, 0), 0, t + 2);
      BAR; WAIT_L(0); MMA(0, 1, At, B1); BAR;
      LDA(At, 0, 1); STA(SA(0, 0), 0, t + 2);
      BAR; WAIT_L(0); MMA(1, 0, At, B0); BAR; SCHED;
      STB(SB(0, 1), 1, t + 2);
      WAIT_V(6); BAR; MMA(1, 1, At, B1); BAR;
      LDB(B0, 1, 0); SCHED; LDA(At, 1, 0); STA(SA(0, 1), 1, t + 2);
      WAIT_L(8); BAR; WAIT_L(0); MMA(0, 0, At, B0); BAR; SCHED;
      LDB(B1, 1, 1); STB(SB(1, 0), 0, t + 3);
      BAR; WAIT_L(0); MMA(0, 1, At, B1); BAR;
      LDA(At, 1, 1); STA(SA(1, 0), 0, t + 3);
      BAR; WAIT_L(0); MMA(1, 0, At, B0); BAR; SCHED;
      STB(SB(1, 1), 1, t + 3);
      WAIT_V(6); BAR; MMA(1, 1, At, B1); BAR;
    }
    { LDB(B0, 0, 0); LDA(At, 0, 0); STA(SA(1, 1), 1, nt - 1);
      BAR; WAIT_L(0); MMA(0, 0, At, B0); BAR;
      LDB(B1, 0, 1); BAR; WAIT_L(0); MMA(0, 1, At, B1); BAR;
      LDA(At, 0, 1); WAIT_V(4); BAR; WAIT_L(0); MMA(1, 0, At, B0); MMA(1, 1, At, B1); BAR; }
    { LDB(B0, 1, 0); LDA(At, 1, 0); WAIT_V(2); BAR; WAIT_L(0); MMA(0, 0, At, B0); BAR;
      LDB(B1, 1, 1); WAIT_V(0); BAR; WAIT_L(0); MMA(0, 1, At, B1); BAR;
      LDA(At, 1, 1); BAR; WAIT_L(0); MMA(1, 0, At, B0); MMA(1, 1, At, B1); BAR; }
    if (wr == 0) BAR;

    const int te = opaque_tid();
    const int wid = te >> 6, lane = te & 63, wr = wid >> 2, wc = wid & 3, fr = lane & 15, fq = lane >> 4;
    const int cond = cond_of_row(brow);
    if (EPI == EPI_RES) {
      const float* gate = mods_ptr(p, ga.layer, cond, ga.gidx);
      UNR for (int ai = 0; ai < 2; ++ai) UNR for (int bj = 0; bj < 2; ++bj) UNR for (int m = 0; m < 4; ++m) UNR for (int n = 0; n < 2; ++n) {
        int row = brow + ai * HALF + wr * 64 + m * 16 + fr, col = bcol + bj * HALF + wc * 32 + n * 16 + fq * 4;
        float4 g4 = *reinterpret_cast<const float4*>(gate + col);
        float4* xp = reinterpret_cast<float4*>(ga.o32 + (long)row * D + col);
        float4 x = *xp; f32x4 a = acc[ai][bj][m][n];
        x.x = DN_ALPHA * x.x + g4.x * a[0]; x.y = DN_ALPHA * x.y + g4.y * a[1];
        x.z = DN_ALPHA * x.z + g4.z * a[2]; x.w = DN_ALPHA * x.w + g4.w * a[3];
        *xp = x;
      }
    } else if (EPI == EPI_GATED) {
      UNR for (int ai = 0; ai < 2; ++ai) UNR for (int m = 0; m < 4; ++m) UNR for (int n = 0; n < 2; ++n) {
        int row = brow + ai * HALF + wr * 64 + m * 16 + fr, col = pn * HALF + wc * 32 + n * 16 + fq * 4;
        f32x4 a = acc[ai][0][m][n], b = acc[ai][1][m][n]; float r[4];
        UNR for (int j = 0; j < 4; ++j) r[j] = ga.act == 0 ? a[j] * fast_sigmoid(a[j]) * b[j] : a[j] * fast_sigmoid(b[j]);
        uint2 o; o.x = pack2(r[0], r[1]); o.y = pack2(r[2], r[3]);
        *reinterpret_cast<uint2*>(ga.o16 + (long)row * ga.ldo + col) = o;
      }
    } else if (EPI == EPI_PLAIN) {
      UNR for (int ai = 0; ai < 2; ++ai) UNR for (int bj = 0; bj < 2; ++bj) UNR for (int m = 0; m < 4; ++m) UNR for (int n = 0; n < 2; ++n) {
        int row = brow + ai * HALF + wr * 64 + m * 16 + fr, col = bcol + bj * HALF + wc * 32 + n * 16 + fq * 4;
        f32x4 a = acc[ai][bj][m][n]; uint2 o; o.x = pack2(a[0], a[1]); o.y = pack2(a[2], a[3]);
        *reinterpret_cast<uint2*>(ga.o16 + (long)row * ga.ldo + col) = o;
      }
    } else if (EPI == EPI_S) {
      UNR for (int ai = 0; ai < 2; ++ai) UNR for (int bj = 0; bj < 2; ++bj) UNR for (int m = 0; m < 4; ++m) UNR for (int n = 0; n < 2; ++n) {
        int R = brow + ai * HALF + wr * 64 + m * 16 + fr, col = bj * HALF + wc * 32 + n * 16 + fq * 4;
        f32x4 a = acc[ai][bj][m][n];
        *reinterpret_cast<float4*>(ga.o32 + ((long)R * 64 + grp) * 256 + col) = make_float4(a[0], a[1], a[2], a[3]);
      }
    } else if (EPI == EPI_Y) {
      UNR for (int ai = 0; ai < 2; ++ai) UNR for (int bj = 0; bj < 2; ++bj) UNR for (int m = 0; m < 4; ++m) UNR for (int n = 0; n < 2; ++n) {
        int R = brow + ai * HALF + wr * 64 + m * 16 + fr, tau = bj * 8 + wc * 2 + n;
        f32x4 a = acc[ai][bj][m][n]; uint2 o;
        o.x = pack2(gelu_tanh(a[0]), gelu_tanh(a[1])); o.y = pack2(gelu_tanh(a[2]), gelu_tanh(a[3]));
        *reinterpret_cast<uint2*>(ga.o16 + ((long)R * 16 + tau) * 1024 + grp * 16 + fq * 4) = o;
      }
    } else {
      u16* Q = (u16*)(p.ws + OFF_R1 + R1_Q); u16* KB = (u16*)(p.ws + OFF_R1 + R1_KB); u16* VT = (u16*)(p.ws + OFF_R1 + R1_VT);
      const float* rope = (const float*)(p.ws + OFF_ROPE);
      const bool is_ctx = brow < MCTX;
      if (pn < 4) {
        UNR for (int ai = 0; ai < 2; ++ai) UNR for (int bj = 0; bj < 2; ++bj) UNR for (int m = 0; m < 4; ++m) UNR for (int n = 0; n < 2; ++n) {
          int row = brow + ai * HALF + wr * 64 + m * 16 + fr, col = bcol + bj * HALF + wc * 32 + n * 16 + fq * 4;
          f32x4 a = acc[ai][bj][m][n]; uint2 o; o.x = pack2(a[0], a[1]); o.y = pack2(a[2], a[3]);
          *reinterpret_cast<uint2*>(Q + (long)row * 1024 + col) = o;
        }
      } else if (pn == 4) {
        UNR for (int ai = 0; ai < 2; ++ai) UNR for (int bj = 0; bj < 2; ++bj) UNR for (int m = 0; m < 4; ++m) {
          int row = brow + ai * HALF + wr * 64 + m * 16 + fr, c0 = bj * HALF + wc * 32 + fq * 4;
          f32x4 x1 = acc[ai][bj][m][0], x2 = acc[ai][bj][m][1];
          if (is_ctx) {
            int b = row >> 8, t = row & 255;
            float* ck = p.out + OUT_CK + ((long)(b * 2 + ga.attn_a) * 256 + t) * 256;
            *reinterpret_cast<float4*>(ck + c0) = make_float4(x1[0], x1[1], x1[2], x1[3]);
            *reinterpret_cast<float4*>(ck + c0 + 16) = make_float4(x2[0], x2[1], x2[2], x2[3]);
          } else {
            int t = (row - MCTX) & 4095; int pos = (wc & 1) ? (t & 63) : (t >> 6);
            const float* cs = rope + (pos * 16 + fq * 4) * 2;
            float4 cs01 = *reinterpret_cast<const float4*>(cs), cs23 = *reinterpret_cast<const float4*>(cs + 4);
            float cc[4] = {cs01.x, cs01.z, cs23.x, cs23.z}, ss[4] = {cs01.y, cs01.w, cs23.y, cs23.w};
            UNR for (int j = 0; j < 4; ++j) { float a = x1[j], b2 = x2[j]; x1[j] = a * cc[j] - b2 * ss[j]; x2[j] = a * ss[j] + b2 * cc[j]; }
          }
          uint2 o1, o2; o1.x = pack2(x1[0], x1[1]); o1.y = pack2(x1[2], x1[3]); o2.x = pack2(x2[0], x2[1]); o2.y = pack2(x2[2], x2[3]);
          *reinterpret_cast<uint2*>(KB + (long)row * 256 + c0) = o1;
          *reinterpret_cast<uint2*>(KB + (long)row * 256 + c0 + 16) = o2;
        }
      } else {
        UNR for (int ai = 0; ai < 2; ++ai) UNR for (int bj = 0; bj < 2; ++bj) UNR for (int m = 0; m < 4; ++m) UNR for (int n = 0; n < 2; ++n) {
          int row = brow + ai * HALF + wr * 64 + m * 16 + fr, c0 = bj * HALF + wc * 32 + n * 16 + fq * 4;
          f32x4 a = acc[ai][bj][m][n];
          if (is_ctx) {
            int b = row >> 8, t = row & 255;
            float* cv = p.out + OUT_CV + ((long)(b * 2 + ga.attn_a) * 256 + t) * 256;
            *reinterpret_cast<float4*>(cv + c0) = make_float4(a[0], a[1], a[2], a[3]);
            u16* vt = VT + ((long)b * 256 + c0) * 256 + t;
            UNR for (int j = 0; j < 4; ++j) vt[j * 256] = f2bf(a[j]);
          } else {
            int b = (row - MCTX) >> 12, t = (row - MCTX) & 4095;
            u16* vt = VT + (long)16 * 256 * 256 + ((long)b * 256 + c0) * 4096 + t;
            UNR for (int j = 0; j < 4; ++j) vt[j * 4096] = f2bf(a[j]);
          }
        }
      }
    }
    WAIT_V(0);
    BAR;
  }
#undef SA
#undef SB
}

#define MFMA32(a, b, c) __builtin_amdgcn_mfma_f32_32x32x16_bf16((a), (b), (c), 0, 0, 0)

struct KVTile { bf16x8 k[4]; bf16x8 v[2][2]; };

DI void load_kv(KVTile& t, const u16* Kb, const u16* Vb, long vstride, int key0, int l32, int h) {
  const int kperm = (l32 & ~12) | ((l32 & 4) << 1) | ((l32 & 8) >> 1);
  const uint4* kp = reinterpret_cast<const uint4*>(Kb + (long)(key0 + kperm) * 256 + h * 32);
#pragma unroll
  for (int kk = 0; kk < 4; ++kk) t.k[kk] = __builtin_bit_cast(bf16x8, kp[kk]);
#pragma unroll
  for (int dt = 0; dt < 2; ++dt)
#pragma unroll
    for (int k2 = 0; k2 < 2; ++k2)
      t.v[dt][k2] = __builtin_bit_cast(bf16x8, *reinterpret_cast<const uint4*>(Vb + (long)(dt * 32 + l32) * vstride + key0 + 16 * k2 + 8 * h));
}

template <bool MASK>
DI void attn_tile(const KVTile& t, const bf16x8 (&q)[2][4], f32x16 (&O)[2][2], float (&mrow)[2], float (&lrow)[2],
                  int key0, int qpos0, int h, float c1) {
#pragma unroll
  for (int qt = 0; qt < 2; ++qt) {
    f32x16 S;
#pragma unroll
    for (int i = 0; i < 16; ++i) S[i] = 0.f;
#pragma unroll
    for (int kk = 0; kk < 4; ++kk) S = MFMA32(t.k[kk], q[qt][kk], S);
    float mx = -3.0e38f;
#pragma unroll
    for (int r = 0; r < 16; ++r) {
      float s = S[r] * c1;
      if (MASK) {
        int kpos = key0 + 16 * (r >> 3) + 8 * h + (r & 7);
        int dlt = qpos0 + qt * 32 - kpos;
        if (dlt > 128 || dlt < -128) s = -1.0e30f;
      }
      S[r] = s; mx = fmaxf(mx, s);
    }
    mx = fmaxf(mx, __shfl_xor(mx, 32));
    float mnew = fmaxf(mrow[qt], mx);
    float alpha = exp2f(mrow[qt] - mnew);
    mrow[qt] = mnew;
    float rs = 0.f;
#pragma unroll
    for (int r = 0; r < 16; ++r) { float pv = exp2f(S[r] - mnew); S[r] = pv; rs += pv; }
    rs += __shfl_xor(rs, 32);
    lrow[qt] = lrow[qt] * alpha + rs;
#pragma unroll
    for (int dt = 0; dt < 2; ++dt)
#pragma unroll
      for (int r = 0; r < 16; ++r) O[qt][dt][r] *= alpha;
    bf16x8 pk[2];
#pragma unroll
    for (int k2 = 0; k2 < 2; ++k2) {
      uint4 u;
      u.x = pack2(S[8 * k2 + 0], S[8 * k2 + 1]); u.y = pack2(S[8 * k2 + 2], S[8 * k2 + 3]);
      u.z = pack2(S[8 * k2 + 4], S[8 * k2 + 5]); u.w = pack2(S[8 * k2 + 6], S[8 * k2 + 7]);
      pk[k2] = __builtin_bit_cast(bf16x8, u);
    }
#pragma unroll
    for (int dt = 0; dt < 2; ++dt)
#pragma unroll
      for (int k2 = 0; k2 < 2; ++k2) O[qt][dt] = MFMA32(t.v[dt][k2], pk[k2], O[qt][dt]);
  }
}

DI void attn_phase(const Params& p, int a) {
  const u16* Q = (const u16*)(p.ws + OFF_R1 + R1_Q); const u16* KB = (const u16*)(p.ws + OFF_R1 + R1_KB);
  const u16* VT = (const u16*)(p.ws + OFF_R1 + R1_VT); u16* Og = (u16*)(p.ws + OFF_R1 + R1_O);
  const u16* KC = (const u16*)(p.ws + OFF_KC); const u16* VTC = (const u16*)(p.ws + OFF_VTC);
  const float* rope = (const float*)(p.ws + OFF_ROPE);
  const int tidx = opaque_tid();
  const int wid = tidx >> 6, lane = tidx & 63, l32 = lane & 31, h = lane >> 5;
  const float LOG2E = 1.4426950408889634f, c1 = 0.125f * LOG2E;
  for (int it = blockIdx.x; it < 1152; it += gridDim.x) {
    const bool lat = it < 1024;
    int seq, qblk, kvh;
    if (lat) { kvh = it & 3; qblk = (it >> 2) & 31; seq = it >> 7; } else { int j = it - 1024; kvh = j & 3; qblk = (j >> 2) & 1; seq = j >> 3; }
    const int head = kvh * 4 + (wid >> 1);
    const int q0 = qblk * 128 + (wid & 1) * 64;
    const long rowbase = lat ? (long)MCTX + (long)seq * 4096 : (long)seq * 256;
    bf16x8 q[2][4];
#pragma unroll
    for (int qt = 0; qt < 2; ++qt) {
      const uint4* qp = reinterpret_cast<const uint4*>(Q + (rowbase + q0 + qt * 32 + l32) * 1024 + head * 64 + h * 32);
#pragma unroll
      for (int kk = 0; kk < 4; ++kk) q[qt][kk] = __builtin_bit_cast(bf16x8, qp[kk]);
    }
    const float sk = p.sink[a * 16 + head] * LOG2E;
    float mrow[2] = {sk, sk}, lrow[2] = {1.f, 1.f};
    f32x16 O[2][2];
#pragma unroll
    for (int qt = 0; qt < 2; ++qt)
#pragma unroll
      for (int dt = 0; dt < 2; ++dt)
#pragma unroll
        for (int r = 0; r < 16; ++r) O[qt][dt][r] = 0.f;
    {
      const u16* Kb; const u16* Vb; long vs; int nk;
      if (lat) { Kb = KC + ((long)(seq * 2 + a) * 512) * 256 + kvh * 64; Vb = VTC + ((long)(seq * 2 + a) * 256 + kvh * 64) * 512; vs = 512; nk = 512; }
      else { Kb = KB + rowbase * 256 + kvh * 64; Vb = VT + ((long)seq * 256 + kvh * 64) * 256; vs = 256; nk = 256; }
      KVTile cur, nxt;
      load_kv(cur, Kb, Vb, vs, 0, l32, h);
      for (int key0 = 0; key0 < nk; key0 += 32) {
        int kn = key0 + 32 < nk ? key0 + 32 : key0;
        load_kv(nxt, Kb, Vb, vs, kn, l32, h);
        attn_tile<false>(cur, q, O, mrow, lrow, key0, 0, h, c1);
        cur = nxt;
      }
    }
    if (lat) {
#pragma unroll
      for (int qt = 0; qt < 2; ++qt) {
        int t = q0 + qt * 32 + l32; int pos = h ? (t & 63) : (t >> 6);
#pragma unroll
        for (int kk = 0; kk < 2; ++kk) {
          const float4* cs = reinterpret_cast<const float4*>(rope + (pos * 16 + kk * 8) * 2);
#pragma unroll
          for (int e2 = 0; e2 < 4; ++e2) {
            float4 c4 = cs[e2];
            float cA = c4.x, sA = c4.y, cB = c4.z, sB = c4.w;
            float x1 = bf2f((u16)q[qt][kk][2 * e2]), x2 = bf2f((u16)q[qt][kk + 2][2 * e2]);
            q[qt][kk][2 * e2] = (short)f2bf(x1 * cA - x2 * sA); q[qt][kk + 2][2 * e2] = (short)f2bf(x1 * sA + x2 * cA);
            x1 = bf2f((u16)q[qt][kk][2 * e2 + 1]); x2 = bf2f((u16)q[qt][kk + 2][2 * e2 + 1]);
            q[qt][kk][2 * e2 + 1] = (short)f2bf(x1 * cB - x2 * sB); q[qt][kk + 2][2 * e2 + 1] = (short)f2bf(x1 * sB + x2 * cB);
          }
        }
      }
      const u16* Kb = KB + rowbase * 256 + kvh * 64;
      const u16* Vb = VT + (long)16 * 256 * 256 + ((long)seq * 256 + kvh * 64) * 4096;
      const int lo = max(0, q0 - 128), hi = min(4096, q0 + 192);
      KVTile cur, nxt;
      load_kv(cur, Kb, Vb, 4096, lo, l32, h);
      for (int key0 = lo; key0 < hi; key0 += 32) {
        int kn = key0 + 32 < hi ? key0 + 32 : key0;
        load_kv(nxt, Kb, Vb, 4096, kn, l32, h);
        attn_tile<true>(cur, q, O, mrow, lrow, key0, q0 + l32, h, c1);
        cur = nxt;
      }
    }
#pragma unroll
    for (int qt = 0; qt < 2; ++qt) {
      float inv = 1.f / lrow[qt];
      u16* op = Og + (rowbase + q0 + qt * 32 + l32) * 1024 + head * 64 + 4 * h;
#pragma unroll
      for (int dt = 0; dt < 2; ++dt)
#pragma unroll
        for (int g4 = 0; g4 < 4; ++g4) {
          uint2 o; o.x = pack2(O[qt][dt][4 * g4] * inv, O[qt][dt][4 * g4 + 1] * inv);
          o.y = pack2(O[qt][dt][4 * g4 + 2] * inv, O[qt][dt][4 * g4 + 3] * inv);
          *reinterpret_cast<uint2*>(op + dt * 32 + 8 * g4) = o;
        }
    }
  }
}

DI void row_phase(const Params& p, int mode, int ln_layer, int ln_idx, int mod_layer, int mod_idx) {
  float* X = (float*)(p.ws + OFF_X); u16* H = (u16*)(p.ws + OFF_H);
  const int tidx = opaque_tid();
  const int lane = tidx & 63, gw = blockIdx.x * 8 + (tidx >> 6), nw = gridDim.x * 8;
  float4 g4[4], b4[4];
  if (mode != 0) {
    const float* g = p.ln_g + (ln_layer * 2 + ln_idx) * 1024; const float* b = p.ln_b + (ln_layer * 2 + ln_idx) * 1024;
    UNR for (int j = 0; j < 4; ++j) { g4[j] = *reinterpret_cast<const float4*>(g + j * 256 + lane * 4); b4[j] = *reinterpret_cast<const float4*>(b + j * 256 + lane * 4); }
  }
  for (int row = gw; row < MTOK; row += nw) {
    float4 v[4];
    const float* src = mode == 0 ? (row < MCTX ? p.x_prompt + (long)row * D : p.x_sample + (long)(row - MCTX) * D) : X + (long)row * D;
    UNR for (int j = 0; j < 4; ++j) v[j] = *reinterpret_cast<const float4*>(src + j * 256 + lane * 4);
    if (mode != 0) {
      float s = 0.f;
      UNR for (int j = 0; j < 4; ++j) s += v[j].x + v[j].y + v[j].z + v[j].w;
      float mu = wave_sum(s) * (1.f / 1024.f);
      float q = 0.f;
      UNR for (int j = 0; j < 4; ++j) { v[j].x -= mu; v[j].y -= mu; v[j].z -= mu; v[j].w -= mu; q += v[j].x * v[j].x + v[j].y * v[j].y + v[j].z * v[j].z + v[j].w * v[j].w; }
      float rstd = rsqrtf(wave_sum(q) * (1.f / 1024.f) + LN_EPS);
      UNR for (int j = 0; j < 4; ++j) {
        v[j].x = v[j].x * rstd * g4[j].x + b4[j].x; v[j].y = v[j].y * rstd * g4[j].y + b4[j].y;
        v[j].z = v[j].z * rstd * g4[j].z + b4[j].z; v[j].w = v[j].w * rstd * g4[j].w + b4[j].w;
      }
    }
    if (mode == 2) {
      UNR for (int j = 0; j < 4; ++j) *reinterpret_cast<float4*>(p.out + (long)row * D + j * 256 + lane * 4) = v[j];
    } else {
      const int cond = cond_of_row(row);
      const float* sh = mods_ptr(p, mod_layer, cond, mod_idx); const float* sc = mods_ptr(p, mod_layer, cond, mod_idx + 1);
      UNR for (int j = 0; j < 4; ++j) {
        *reinterpret_cast<float4*>(X + (long)row * D + j * 256 + lane * 4) = v[j];
        float4 s4 = *reinterpret_cast<const float4*>(sh + j * 256 + lane * 4), c4 = *reinterpret_cast<const float4*>(sc + j * 256 + lane * 4);
        uint2 o; o.x = pack2(v[j].x * (1.f + c4.x) + s4.x, v[j].y * (1.f + c4.y) + s4.y);
        o.y = pack2(v[j].z * (1.f + c4.z) + s4.z, v[j].w * (1.f + c4.w) + s4.w);
        *reinterpret_cast<uint2*>(H + (long)row * D + j * 256 + lane * 4) = o;
      }
    }
  }
}

DI void conv_w(const float* src, int ld, int K, int N, u16* dst, int mode, int& base) {
  extern __shared__ __attribute__((aligned(16))) __hip_bfloat16 shm[];
  float* lds = (float*)shm;
  const int tidc = opaque_tid();
  const int tn = N >> 6, tiles = (K >> 6) * tn, G = gridDim.x;
  int start = ((int)blockIdx.x - (base % G) + G) % G;
  for (int t = start; t < tiles; t += G) {
    int kt = t / tn, nt = t % tn;
#pragma unroll
    for (int i = 0; i < 8; ++i) { int idx = tidc + 512 * i, kk = idx >> 6, nn = idx & 63; lds[kk * 65 + nn] = src[(long)(kt * 64 + kk) * ld + nt * 64 + nn]; }
    __syncthreads();
    int n = tidc >> 3, k8 = (tidc & 7) * 8, ng = nt * 64 + n;
    int nr = mode == 0 ? ng : ((ng >> 7) * 256 + (mode == 2 ? 128 : 0) + (ng & 127));
    uint4 o;
    o.x = pack2(lds[(k8 + 0) * 65 + n], lds[(k8 + 1) * 65 + n]); o.y = pack2(lds[(k8 + 2) * 65 + n], lds[(k8 + 3) * 65 + n]);
    o.z = pack2(lds[(k8 + 4) * 65 + n], lds[(k8 + 5) * 65 + n]); o.w = pack2(lds[(k8 + 6) * 65 + n], lds[(k8 + 7) * 65 + n]);
    *reinterpret_cast<uint4*>(dst + (long)nr * K + kt * 64 + k8) = o;
    __syncthreads();
  }
  base += tiles;
}

DI void sincos_red(float ang, float& s, float& c) {
  float n = rintf(ang * 0.15915494309189535f);
  float r = fmaf(-n, 6.2831854820251465f, ang);
  r = fmaf(-n, -1.7484555e-7f, r);
  s = __sinf(r); c = __cosf(r);
}

DI void ssm_prep(const Params& p, int s) {
  extern __shared__ __attribute__((aligned(16))) __hip_bfloat16 shm[];
  float* L = (float*)shm;
  float* ap_re = L;
  float* ap_im = ap_re + 2176;
  float* bb_re = ap_im + 2176;
  float* bb_im = bb_re + 2048;
  float* cc_re = bb_im + 2048;
  float* cc_im = cc_re + 2048;
  float* kmat = cc_im + 2048;
  u16* Pt = (u16*)(p.ws + OFF_PT); u16* Tt = (u16*)(p.ws + OFF_TT);
  const int tid = opaque_tid();
  for (int g = blockIdx.x; g < 64; g += gridDim.x) {
    __syncthreads();
    if (tid < 128) {
      int dir = tid >> 6, pp = tid & 63;
      long li = ((long)(s * 2 + dir) * 64 + g) * 64 + pp;
      float lr = p.lam_re[li], lim = p.lam_im[li];
      float dt = __expf(p.log_dt[(s * 2 + dir) * 64 + g]);
      for (int j = 0; j <= 16; ++j) {
        float mag = __expf((float)j * lr * dt), sn, cs;
        sincos_red((float)j * lim * dt, sn, cs);
        ap_re[(dir * 64 + pp) * 17 + j] = mag * cs; ap_im[(dir * 64 + pp) * 17 + j] = mag * sn;
      }
      float ar = ap_re[(dir * 64 + pp) * 17 + 1], ai = ap_im[(dir * 64 + pp) * 17 + 1];
      float den = lr * lr + lim * lim, nr = ar - 1.f, ni = ai;
      float cr = (nr * lr + ni * lim) / den, ci = (ni * lr - nr * lim) / den;
      for (int m = 0; m < 16; ++m) {
        float br = p.b_re[li * 16 + m], bi = p.b_im[li * 16 + m];
        bb_re[(dir * 64 + pp) * 16 + m] = cr * br - ci * bi; bb_im[(dir * 64 + pp) * 16 + m] = cr * bi + ci * br;
      }
    }
    for (int i = tid; i < 2048; i += 512) {
      int dir = i >> 10, r = i & 1023;
      long ci = ((long)(s * 2 + dir) * 64 + g) * 1024 + r;
      cc_re[i] = p.c_re[ci]; cc_im[i] = p.c_im[ci];
    }
    __syncthreads();
    {
      int dir = tid >> 8, j = (tid >> 4) & 15, m = tid & 15;
      float acc[16];
#pragma unroll
      for (int i = 0; i < 16; ++i) acc[i] = 0.f;
      for (int pp = 0; pp < 64; ++pp) {
        float cr = cc_re[(dir * 16 + m) * 64 + pp], ci = cc_im[(dir * 16 + m) * 64 + pp];
        float ar = ap_re[(dir * 64 + pp) * 17 + j], ai = ap_im[(dir * 64 + pp) * 17 + j];
        float xr = cr * ar - ci * ai, xi = cr * ai + ci * ar;
#pragma unroll
        for (int i = 0; i < 16; ++i) acc[i] += xr * bb_re[(dir * 64 + pp) * 16 + i] - xi * bb_im[(dir * 64 + pp) * 16 + i];
      }
#pragma unroll
      for (int i = 0; i < 16; ++i) kmat[((dir * 16 + j) * 16 + m) * 16 + i] = acc[i];
    }
    __syncthreads();
    for (int gi = tid; gi < 256 * 64; gi += 512) {
      int n = gi >> 6, k0 = (gi & 63) * 8, tau = n >> 4, m = n & 15;
      float v[8];
      if (k0 < 256) {
        int sg = k0 >> 4, mp0 = k0 & 15;
#pragma unroll
        for (int e = 0; e < 8; ++e) {
          int mp = mp0 + e; float x = 0.f;
          if (sg <= tau) x += kmat[((0 * 16 + (tau - sg)) * 16 + m) * 16 + mp];
          if (sg >= tau) x += kmat[((1 * 16 + (sg - tau)) * 16 + m) * 16 + mp];
          if (sg == tau && mp == m) x += p.ssm_d[s * 1024 + g * 16 + m];
          v[e] = x;
        }
      } else {
        int qq = k0 - 256, dir = qq >> 7, p0 = (qq & 127) >> 1;
        int ex = dir == 0 ? tau + 1 : 16 - tau;
#pragma unroll
        for (int e2 = 0; e2 < 4; ++e2) {
          int pp = p0 + e2;
          float cr = cc_re[(dir * 16 + m) * 64 + pp], ci = cc_im[(dir * 16 + m) * 64 + pp];
          float ar = ap_re[(dir * 64 + pp) * 17 + ex], ai = ap_im[(dir * 64 + pp) * 17 + ex];
          v[2 * e2] = cr * ar - ci * ai; v[2 * e2 + 1] = -(cr * ai + ci * ar);
        }
      }
      uint4 o; o.x = pack2(v[0], v[1]); o.y = pack2(v[2], v[3]); o.z = pack2(v[4], v[5]); o.w = pack2(v[6], v[7]);
      *reinterpret_cast<uint4*>(Tt + ((long)g * 256 + n) * 512 + k0) = o;
    }
    for (int gi = tid; gi < 256 * 32; gi += 512) {
      int n = gi >> 5, k0 = (gi & 31) * 8, dir = n >> 7, pp = (n & 127) >> 1, ri = n & 1;
      int sg = k0 >> 4, mp0 = k0 & 15, ex = dir == 0 ? 15 - sg : sg;
      float ar = ap_re[(dir * 64 + pp) * 17 + ex], ai = ap_im[(dir * 64 + pp) * 17 + ex];
      float v[8];
#pragma unroll
      for (int e = 0; e < 8; ++e) {
        float br = bb_re[(dir * 64 + pp) * 16 + mp0 + e], bi = bb_im[(dir * 64 + pp) * 16 + mp0 + e];
        v[e] = ri ? (ar * bi + ai * br) : (ar * br - ai * bi);
      }
      uint4 o; o.x = pack2(v[0], v[1]); o.y = pack2(v[2], v[3]); o.z = pack2(v[4], v[5]); o.w = pack2(v[6], v[7]);
      *reinterpret_cast<uint4*>(Pt + ((long)g * 256 + n) * 256 + k0) = o;
    }
  }
  __syncthreads();
}

DI void conv_layer(const Params& p, int l) {
  int base = 0;
  char* ws = p.ws;
  if ((l & 1) == 0) {
    int a = l >> 1;
    conv_w(p.w_qkv + (long)a * 1024 * 1536, 1536, 1024, 1536, (u16*)(ws + OFF_WA), 0, base);
    conv_w(p.w_o + (long)a * 1024 * 1024, 1024, 1024, 1024, (u16*)(ws + OFF_WB), 0, base);
  } else {
    int s = l >> 1;
    conv_w(p.ssm_w_in + (long)s * 1024 * 1024, 1024, 1024, 1024, (u16*)(ws + OFF_WA), 0, base);
    conv_w(p.w_out + (long)s * 1024 * 1024, 1024, 1024, 1024, (u16*)(ws + OFF_WB), 0, base);
    conv_w(p.w_glu + (long)s * 1024 * 2048, 2048, 1024, 1024, (u16*)(ws + OFF_WGLU), 1, base);
    conv_w(p.w_glu + (long)s * 1024 * 2048 + 1024, 2048, 1024, 1024, (u16*)(ws + OFF_WGLU), 2, base);
  }
  conv_w(p.w1 + (long)l * 1024 * DFF, DFF, 1024, DFF, (u16*)(ws + OFF_W13), 1, base);
  conv_w(p.w3 + (long)l * 1024 * DFF, DFF, 1024, DFF, (u16*)(ws + OFF_W13), 2, base);
  conv_w(p.w2 + (long)l * DFF * 1024, 1024, DFF, 1024, (u16*)(ws + OFF_W2), 0, base);
  if (l & 1) ssm_prep(p, l >> 1);
}

DI void prep_phase(const Params& p) {
  extern __shared__ __attribute__((aligned(16))) __hip_bfloat16 shm[];
  float* L = (float*)shm;
  const int tid = opaque_tid();
  for (int it = blockIdx.x; it < 192; it += gridDim.x) {
    float* sc = L;
    float* red = L + 9216;
    __syncthreads();
    for (int i = tid; i < 9216; i += 512) {
      int cd = i >> 10, k = i & 1023;
      float v = cd == 0 ? p.c_ctx[k] : p.c[(cd - 1) * 1024 + k];
      sc[i] = v * fast_sigmoid(v);
    }
    __syncthreads();
    int cidx = it * 128 + (tid & 127), ks = tid >> 7, l = cidx / 6144, col = cidx % 6144;
    const float* w = p.w_ada + ((long)l * 1024 + ks * 256) * 6144 + col;
    float acc[9];
#pragma unroll
    for (int i = 0; i < 9; ++i) acc[i] = 0.f;
    for (int k = 0; k < 256; ++k) {
      float wv = w[(long)k * 6144];
#pragma unroll
      for (int i = 0; i < 9; ++i) acc[i] += sc[i * 1024 + ks * 256 + k] * wv;
    }
#pragma unroll
    for (int i = 0; i < 9; ++i) red[(ks * 9 + i) * 128 + (tid & 127)] = acc[i];
    __syncthreads();
    if (tid < 128) {
      float bia = p.b_ada[l * 6144 + col];
      float* mo = (float*)(p.ws + OFF_MODS);
#pragma unroll
      for (int i = 0; i < 9; ++i) {
        float v = red[(0 * 9 + i) * 128 + tid] + red[(1 * 9 + i) * 128 + tid] + red[(2 * 9 + i) * 128 + tid] + red[(3 * 9 + i) * 128 + tid] + bia;
        mo[((long)(l * 9 + i)) * 6144 + col] = v;
      }
    }
    __syncthreads();
  }
  if (blockIdx.x == gridDim.x - 1) {
    float* rope = (float*)(p.ws + OFF_ROPE);
    for (int i = tid; i < 1024; i += 512) {
      int pos = i >> 4, f = i & 15;
      float inv = exp2f(-(float)f * (13.287712379549449f / 16.f));
      float sn, cs; sincos_red((float)pos * inv, sn, cs);
      rope[i * 2] = cs; rope[i * 2 + 1] = sn;
    }
  }
  {
    u16* KC = (u16*)(p.ws + OFF_KC); u16* VTC = (u16*)(p.ws + OFF_VTC);
    const long nthr = (long)gridDim.x * 512, gt = (long)blockIdx.x * 512 + tid;
    for (long i = gt; i < 2097152 / 4; i += nthr) {
      float4 v = *reinterpret_cast<const float4*>(p.cache_k + i * 4);
      uint2 o; o.x = pack2(v.x, v.y); o.y = pack2(v.z, v.w);
      *reinterpret_cast<uint2*>(KC + i * 4) = o;
    }
    for (long i = gt; i < 16L * 64 * 256; i += nthr) {
      int col = (int)(i & 255), kg = (int)((i >> 8) & 63), ba = (int)(i >> 14);
      const float* src = p.cache_v + ((long)ba * 512 + kg * 8) * 256 + col;
      float v[8];
#pragma unroll
      for (int e = 0; e < 8; ++e) v[e] = src[e * 256];
      uint4 o; o.x = pack2(v[0], v[1]); o.y = pack2(v[2], v[3]); o.z = pack2(v[4], v[5]); o.w = pack2(v[6], v[7]);
      *reinterpret_cast<uint4*>(VTC + ((long)ba * 256 + col) * 512 + kg * 8) = o;
    }
  }
  __syncthreads();
  conv_layer(p, 0);
}

DI void scan_phase(const Params& p, int s) {
  const float* S = (const float*)(p.ws + OFF_R1 + R1_S);
  u16* Hin = (u16*)(p.ws + OFF_H);
  const int tidx = opaque_tid();
  const int lane = tidx & 63, gw = blockIdx.x * 8 + (tidx >> 6), nw = gridDim.x * 8;
  for (int it = gw; it < 3072; it += nw) {
    const bool lat = it < 1024;
    int seq, g, dir, nch, R0;
    if (lat) { dir = it & 1; g = (it >> 1) & 63; seq = it >> 7; nch = 256; R0 = 256 + seq * 256; }
    else { int j = it - 1024; dir = j & 1; g = (j >> 1) & 63; seq = j >> 7; nch = 16; R0 = seq * 16; }
    long li = ((long)(s * 2 + dir) * 64 + g) * 64 + lane;
    float dt = __expf(p.log_dt[(s * 2 + dir) * 64 + g]);
    float mag = __expf(16.f * p.lam_re[li] * dt), sn, cs;
    sincos_red(16.f * p.lam_im[li] * dt, sn, cs);
    const float ar = mag * cs, ai = mag * sn;
    float hr = 0.f, hi = 0.f;
    if (lat) { long si = ((long)((seq * 2 + s) * 2 + dir) * 64 + g) * 64 + lane; hr = p.st_re[si]; hi = p.st_im[si]; }
    const long off = (long)g * 256 + dir * 128 + 2 * lane;
    for (int c0 = 0; c0 < nch; c0 += 16) {
      float2 sv[16];
#pragma unroll
      for (int i = 0; i < 16; ++i) {
        int c = dir == 0 ? c0 + i : nch - 1 - (c0 + i);
        sv[i] = *reinterpret_cast<const float2*>(S + (long)(R0 + c) * 16384 + off);
      }
#pragma unroll
      for (int i = 0; i < 16; ++i) {
        int c = dir == 0 ? c0 + i : nch - 1 - (c0 + i);
        *reinterpret_cast<unsigned*>(Hin + (long)(R0 + c) * 16384 + off) = pack2(hr, hi);
        float nr = ar * hr - ai * hi + sv[i].x, ni = ar * hi + ai * hr + sv[i].y;
        hr = nr; hi = ni;
      }
    }
    if (!lat) {
      long oi = ((long)((seq * 2 + s) * 2 + dir) * 64 + g) * 64 + lane;
      p.out[OUT_SR + oi] = hr; p.out[OUT_SI + oi] = hi;
    }
  }
}

constexpr int NPHASE = 36;

DI void ffn1(const Params& p, int l) {
  GemmArgs g{}; g.A = (const u16*)(p.ws + OFF_H); g.lda = 1024; g.Bt = (const u16*)(p.ws + OFF_W13); g.K = 1024; g.nM = 144; g.nN = 22;
  g.act = 0; g.ldo = DFF; g.o16 = (u16*)(p.ws + OFF_R1);
  gemm_phase<0, EPI_GATED>(p, g);
}
DI void res_gemm(const Params& p, int l, const u16* A, int lda, const u16* Bt, int K, int gidx) {
  GemmArgs g{}; g.A = A; g.lda = lda; g.Bt = Bt; g.K = K; g.nM = 144; g.nN = 4; g.layer = l; g.gidx = gidx; g.o32 = (float*)(p.ws + OFF_X);
  gemm_phase<0, EPI_RES>(p, g);
}

DI void run_phase(const Params& p, int ph) {
  if (ph == 0) { prep_phase(p); return; }
  if (ph == 1) { row_phase(p, 0, 0, 0, 0, 0); return; }
  int q = ph - 2, l, sub;
  if (q < 7) { l = 0; sub = q; } else if (q < 17) { l = 1; sub = q - 7; } else if (q < 24) { l = 2; sub = q - 17; } else { l = 3; sub = q - 24; }
  const bool is_attn = (l & 1) == 0;
  int tail = is_attn ? sub - 3 : sub - 6;
  if (tail < 0) {
    if (is_attn) {
      if (sub == 0) {
        GemmArgs g{}; g.A = (const u16*)(p.ws + OFF_H); g.lda = 1024; g.Bt = (const u16*)(p.ws + OFF_WA); g.K = 1024; g.nM = 144; g.nN = 6; g.attn_a = l >> 1;
        gemm_phase<0, EPI_QKV>(p, g);
      } else if (sub == 1) {
        attn_phase(p, l >> 1);
      } else {
        res_gemm(p, l, (const u16*)(p.ws + OFF_R1 + R1_O), 1024, (const u16*)(p.ws + OFF_WB), 1024, 2);
      }
    } else {
      if (sub == 0) {
        GemmArgs g{}; g.A = (const u16*)(p.ws + OFF_H); g.lda = 1024; g.Bt = (const u16*)(p.ws + OFF_WA); g.K = 1024; g.nM = 144; g.nN = 4;
        g.ldo = 1024; g.o16 = (u16*)(p.ws + OFF_R1 + R1_U);
        gemm_phase<0, EPI_PLAIN>(p, g);
      } else if (sub == 1) {
        GemmArgs g{}; g.A = (const u16*)(p.ws + OFF_R1 + R1_U); g.Bt = (const u16*)(p.ws + OFF_PT); g.K = 256; g.nM = 9; g.nN = 1;
        g.o32 = (float*)(p.ws + OFF_R1 + R1_S);
        gemm_phase<1, EPI_S>(p, g);
      } else if (sub == 2) {
        scan_phase(p, l >> 1);
      } else if (sub == 3) {
        GemmArgs g{}; g.A = (const u16*)(p.ws + OFF_R1 + R1_U); g.A2 = (const u16*)(p.ws + OFF_H); g.Bt = (const u16*)(p.ws + OFF_TT); g.K = 512; g.nM = 9; g.nN = 1;
        g.o16 = (u16*)(p.ws + OFF_R1 + R1_U);
        gemm_phase<2, EPI_Y>(p, g);
      } else if (sub == 4) {
        GemmArgs g{}; g.A = (const u16*)(p.ws + OFF_R1 + R1_U); g.lda = 1024; g.Bt = (const u16*)(p.ws + OFF_WGLU); g.K = 1024; g.nM = 144; g.nN = 8;
        g.act = 1; g.ldo = 1024; g.o16 = (u16*)(p.ws + OFF_R1 + R1_GL);
        gemm_phase<0, EPI_GATED>(p, g);
      } else {
        res_gemm(p, l, (const u16*)(p.ws + OFF_R1 + R1_GL), 1024, (const u16*)(p.ws + OFF_WB), 1024, 2);
      }
    }
    return;
  }
  if (tail == 0) { row_phase(p, 1, l, 0, l, 3); return; }
  if (tail == 1) { ffn1(p, l); return; }
  if (tail == 2) { res_gemm(p, l, (const u16*)(p.ws + OFF_R1), DFF, (const u16*)(p.ws + OFF_W2), DFF, 5); return; }
  if (l == 3) { row_phase(p, 2, l, 1, 0, 0); return; }
  row_phase(p, 1, l, 1, l + 1, 0);
  __syncthreads();
  conv_layer(p, l + 1);
}

__global__ void __launch_bounds__(512) mk_forward(Params p, int ph_lo, int ph_hi) {
  for (int ph = ph_lo; ph < ph_hi; ++ph) {
    run_phase(p, ph);
    if (ph + 1 < ph_hi) cg::this_grid().sync();
  }
}

extern "C" void kernel_launch(void* const* d_in, const int* in_sizes, int n_in, void* d_out, int out_size, void* d_ws,
                              size_t ws_size, hipStream_t stream) {
  Params p{};
  const float** f = (const float**)&p;
  for (int i = 0; i < 29; ++i) f[i] = (const float*)d_in[i];
  p.out = (float*)d_out; p.ws = (char*)d_ws;
  static int grid_blocks = 0;
  if (!grid_blocks) {
    hipFuncSetAttribute((const void*)mk_forward, hipFuncAttributeMaxDynamicSharedMemorySize, SHM_B);
    int dev = 0, cus = 0, per_cu = 0;
    hipGetDevice(&dev);
    hipDeviceGetAttribute(&cus, hipDeviceAttributeMultiprocessorCount, dev);
    hipOccupancyMaxActiveBlocksPerMultiprocessor(&per_cu, mk_forward, 512, SHM_B);
    if (per_cu < 1) per_cu = 1;
    grid_blocks = cus * per_cu;
    if (ws_size < WS_TOTAL) fprintf(stderr, "workspace too small: %zu < %zu\n", ws_size, (size_t)WS_TOTAL);
  }
#if ONE_LAUNCH
  int lo = 0, hi = NPHASE;
  void* args[] = {&p, &lo, &hi};
  hipError_t e = hipLaunchCooperativeKernel((void*)mk_forward, dim3(grid_blocks), dim3(512), args, SHM_B, stream);
  if (e != hipSuccess) fprintf(stderr, "cooperative launch failed: %s (grid %d)\n", hipGetErrorString(e), grid_blocks);
#else
  for (int ph = 0; ph < NPHASE; ++ph) mk_forward<<<dim3(grid_blocks), dim3(512), SHM_B, stream>>>(p, ph, ph + 1);
#endif
}
```

```cpp
#include <hip/hip_runtime.h>
#include <hip/hip_bf16.h>
#include <hip/hip_cooperative_groups.h>
#include <cstdio>
namespace cg = cooperative_groups;

#ifndef ONE_LAUNCH
#define ONE_LAUNCH 1
#endif

typedef unsigned short u16;
using bf16x8 = __attribute__((ext_vector_type(8))) short;
using f32x4  = __attribute__((ext_vector_type(4))) float;
using f32x16 = __attribute__((ext_vector_type(16))) float;
#define DI __device__ __forceinline__
#define UNR _Pragma("unroll")

constexpr int D = 1024, DFF = 2816, MCTX = 4096, MLAT = 32768, MTOK = 36864;
constexpr int NCHR = 2304;
constexpr float DN_ALPHA = 1.681792830507429f;
constexpr float LN_EPS = 1e-5f;

constexpr long OUT_CK = 37748736L, OUT_CV = 39845888L, OUT_SR = 41943040L, OUT_SI = 42205184L;

constexpr size_t OFF_MODS = 0;
constexpr size_t OFF_ROPE = 1048576;
constexpr size_t OFF_KC   = OFF_ROPE + 65536;
constexpr size_t OFF_VTC  = OFF_KC + 4194304;
constexpr size_t OFF_STATS = OFF_VTC + 4194304;
constexpr size_t OFF_BAR  = OFF_STATS + 524288;
constexpr size_t OFF_X    = OFF_STATS + 1048576;
constexpr size_t OFF_H    = OFF_X + (size_t)MTOK * 4096;
constexpr size_t OFF_WA   = OFF_H + (size_t)MTOK * 2048;
constexpr size_t OFF_WB   = OFF_WA + 4194304;
constexpr size_t OFF_WGLU = OFF_WB + 2097152;
constexpr size_t OFF_W13  = OFF_WGLU + 4194304;
constexpr size_t OFF_W2   = OFF_W13 + 11534336;
constexpr size_t OFF_PT   = OFF_W2 + 5767168;
constexpr size_t OFF_TT   = OFF_PT + 8388608;
constexpr size_t OFF_R1   = OFF_TT + 16777216;
constexpr size_t R1_Q = 0, R1_KB = (size_t)MTOK * 2048, R1_VT = (size_t)MTOK * 2560, R1_O = (size_t)MTOK * 3072;
constexpr size_t R1_U = 0, R1_S = (size_t)MTOK * 2048, R1_G = (size_t)MTOK * 4096, R1_GL = 0;
constexpr size_t WS_TOTAL = OFF_R1 + (size_t)MTOK * 6144;

struct Params {
  const float *x_prompt, *x_sample, *cache_k, *cache_v, *st_re, *st_im, *c, *c_ctx, *w_ada, *b_ada, *ln_g, *ln_b,
      *w_qkv, *w_o, *sink, *ssm_w_in, *lam_re, *lam_im, *log_dt, *b_re, *b_im, *c_re, *c_im, *ssm_d, *w_glu, *w_out,
      *w1, *w3, *w2;
  float* out;
  char* ws;
};

DI int opaque_tid() {
  int w = __builtin_amdgcn_readfirstlane((int)threadIdx.x >> 6);
  int l;
  asm volatile("v_mbcnt_lo_u32_b32 %0, -1, 0\n\tv_mbcnt_hi_u32_b32 %0, -1, %0" : "=v"(l));
  return (w << 6) | l;
}
typedef __bf16 hwbf16x2 __attribute__((ext_vector_type(2)));
typedef float hwf32x2 __attribute__((ext_vector_type(2)));
DI unsigned pack2(float a, float b) { hwf32x2 v = {a, b}; hwbf16x2 r = __builtin_convertvector(v, hwbf16x2); return __builtin_bit_cast(unsigned, r); }
DI u16 f2bf(float f) { return (u16)(pack2(f, 0.f) & 0xffffu); }
DI float bf2f(u16 h) { return __uint_as_float(((unsigned)h) << 16); }
DI float shfl_xor_l(float v, int lane, int mask) { return __int_as_float(__builtin_amdgcn_ds_bpermute((lane ^ mask) << 2, __float_as_int(v))); }
DI float xhalf_max(float v) { auto r = __builtin_amdgcn_permlane32_swap(__float_as_uint(v), __float_as_uint(v), false, false); return fmaxf(__uint_as_float(r[0]), __uint_as_float(r[1])); }
DI float xhalf_sum(float v) { auto r = __builtin_amdgcn_permlane32_swap(__float_as_uint(v), __float_as_uint(v), false, false); return __uint_as_float(r[0]) + __uint_as_float(r[1]); }
DI float wave_sum(float v, int lane) {
#pragma unroll
  for (int o = 32; o > 0; o >>= 1) v += shfl_xor_l(v, lane, o);
  return v;
}
typedef unsigned u32x2v __attribute__((ext_vector_type(2)));
DI float4 nt_load_f4(const float* p) { f32x4 v = __builtin_nontemporal_load(reinterpret_cast<const f32x4*>(p)); return make_float4(v[0], v[1], v[2], v[3]); }
DI uint2 nt_load_u2(const u16* p) { u32x2v v = __builtin_nontemporal_load(reinterpret_cast<const u32x2v*>(p)); return make_uint2(v[0], v[1]); }
typedef unsigned u32x4v __attribute__((ext_vector_type(4)));
DI uint4 nt_load_u4(const void* p) { u32x4v v = __builtin_nontemporal_load(reinterpret_cast<const u32x4v*>(p)); return make_uint4(v[0], v[1], v[2], v[3]); }
DI void nt_store_f4(float* p, float4 x) { f32x4 v = {x.x, x.y, x.z, x.w}; __builtin_nontemporal_store(v, reinterpret_cast<f32x4*>(p)); }
DI int cond_of_row(int row) { return row < MCTX ? 0 : 1 + ((row - MCTX) >> 12); }
DI const float* mods_ptr(const Params& p, int l, int cond, int idx) {
  return (const float*)(p.ws + OFF_MODS) + ((size_t)((l * 9 + cond) * 6 + idx)) * 1024;
}
DI float fast_sigmoid(float x) { return __builtin_amdgcn_rcpf(1.f + __builtin_amdgcn_exp2f(-1.4426950408889634f * x)); }
DI float gelu_tanh(float x) { float u = 0.7978845608028654f * (x + 0.044715f * x * x * x); return x * fast_sigmoid(2.f * u); }

constexpr int BM = 256, BK = 64, HALF = 128, HT = HALF * BK, SHM_B = 8 * HT * 2;

DI int lds_byte(int r, int c) {
  int st = (r >> 4) * 2 + (c >> 5), rr = r & 15, cc = c & 31, ob = rr * 64 + cc * 2;
  return st * 1024 + (ob ^ (((ob >> 9) & 1) << 5));
}
DI void stage_rc(int b, int& R, int& C) {
  int st = b / 1024, sb = b % 1024, swz = sb ^ (((sb >> 9) & 1) << 5);
  R = (st >> 1) * 16 + swz / 64; C = (st & 1) * 32 + (swz % 64) / 2;
}

constexpr bool SPLITK_TAIL = false;
enum { EPI_QKV = 0, EPI_RES = 1, EPI_GATED = 2, EPI_PLAIN = 3, EPI_S = 4, EPI_Y = 5 };

struct GemmArgs {
  const u16* A;
  const u16* A2;
  const u16* Bt;
  int lda, K, nM, nN;
  int layer;
  int gidx;
  int lnp;
  int act;
  int ldo;
  int attn_a;
  int rev;
  int tbase, sub, ucount;
  u16* o16;
  float* o32;
};

template <int EPI, int MT>
DI void gemm_epilogue(const Params& p, const GemmArgs& ga, f32x4 (&acc)[2][2][MT][2], int brow, int bcol, int pn, int grp) {
  constexpr int MROWS = MT * 16, HROWS = 2 * MROWS;
  {
    const int te = opaque_tid();
    const int wid = te >> 6, lane = te & 63, wr = wid >> 2, wc = wid & 3, fr = lane & 15, fq = lane >> 4;
    const int cond = cond_of_row(brow);
    if (EPI == EPI_RES) {
      const float* stats = (const float*)(p.ws + OFF_STATS);
      const float* lg = p.ln_g + (ga.lnp < 0 ? 0 : ga.lnp) * 1024; const float* lb = p.ln_b + (ga.lnp < 0 ? 0 : ga.lnp) * 1024;
      UNR for (int ai = 0; ai < 2; ++ai) UNR for (int m = 0; m < MT; ++m) {
        const int row = brow + ai * HROWS + wr * MROWS + m * 16 + fr;
        const float* gate = mods_ptr(p, ga.layer, cond_of_row(row), ga.gidx);
        float mu = 0.f, rs = 1.f;
        const float* src = row < MCTX ? p.x_prompt + (long)row * D : p.x_sample + (long)(row - MCTX) * D;
        u16* xb = (u16*)ga.o32 + (long)row * D;
        if (ga.lnp >= 0) { float2 st = *reinterpret_cast<const float2*>(stats + (long)row * 2); mu = st.x; rs = st.y; }
        UNR for (int bj = 0; bj < 2; ++bj) {
          const int col0 = bcol + bj * HALF + wc * 32 + fq * 8;
          float xv[8];
          if (ga.lnp >= 0) {
            uint4 raw = nt_load_u4(xb + col0);
            xv[0] = __uint_as_float(raw.x << 16); xv[1] = __uint_as_float(raw.x & 0xffff0000u); xv[2] = __uint_as_float(raw.y << 16); xv[3] = __uint_as_float(raw.y & 0xffff0000u);
            xv[4] = __uint_as_float(raw.z << 16); xv[5] = __uint_as_float(raw.z & 0xffff0000u); xv[6] = __uint_as_float(raw.w << 16); xv[7] = __uint_as_float(raw.w & 0xffff0000u);
          }
          UNR for (int n = 0; n < 2; ++n) {
            const int col = col0 + n * 4;
            float4 g4 = *reinterpret_cast<const float4*>(gate + col);
            f32x4 a = acc[ai][bj][m][n];
            float4 x;
            if (ga.lnp >= 0) {
              float4 w4 = *reinterpret_cast<const float4*>(lg + col), b4 = *reinterpret_cast<const float4*>(lb + col);
              x.x = (xv[n * 4 + 0] - mu) * rs * w4.x + b4.x; x.y = (xv[n * 4 + 1] - mu) * rs * w4.y + b4.y;
              x.z = (xv[n * 4 + 2] - mu) * rs * w4.z + b4.z; x.w = (xv[n * 4 + 3] - mu) * rs * w4.w + b4.w;
            } else x = nt_load_f4(src + col);
            xv[n * 4 + 0] = DN_ALPHA * x.x + g4.x * a[0]; xv[n * 4 + 1] = DN_ALPHA * x.y + g4.y * a[1];
            xv[n * 4 + 2] = DN_ALPHA * x.z + g4.z * a[2]; xv[n * 4 + 3] = DN_ALPHA * x.w + g4.w * a[3];
          }
          uint4 o; o.x = pack2(xv[0], xv[1]); o.y = pack2(xv[2], xv[3]); o.z = pack2(xv[4], xv[5]); o.w = pack2(xv[6], xv[7]);
          *reinterpret_cast<uint4*>(xb + col0) = o;
        }
      }
    } else if (EPI == EPI_GATED) {
      UNR for (int ai = 0; ai < 2; ++ai) UNR for (int m = 0; m < MT; ++m) {
        const int row = brow + ai * HROWS + wr * MROWS + m * 16 + fr, col = pn * HALF + wc * 32 + fq * 8;
        float r[8];
        UNR for (int n = 0; n < 2; ++n) {
          f32x4 a = acc[ai][0][m][n], b = acc[ai][1][m][n];
          UNR for (int j = 0; j < 4; ++j) r[n * 4 + j] = ga.act == 0 ? a[j] * fast_sigmoid(a[j]) * b[j] : a[j] * fast_sigmoid(b[j]);
        }
        uint4 o; o.x = pack2(r[0], r[1]); o.y = pack2(r[2], r[3]); o.z = pack2(r[4], r[5]); o.w = pack2(r[6], r[7]);
        *reinterpret_cast<uint4*>(ga.o16 + (long)row * ga.ldo + col) = o;
      }
    } else if (EPI == EPI_PLAIN) {
      UNR for (int ai = 0; ai < 2; ++ai) UNR for (int bj = 0; bj < 2; ++bj) UNR for (int m = 0; m < MT; ++m) {
        int row = brow + ai * HROWS + wr * MROWS + m * 16 + fr, col = bcol + bj * HALF + wc * 32 + fq * 8;
        f32x4 a0 = acc[ai][bj][m][0], a1 = acc[ai][bj][m][1];
        uint4 o; o.x = pack2(a0[0], a0[1]); o.y = pack2(a0[2], a0[3]); o.z = pack2(a1[0], a1[1]); o.w = pack2(a1[2], a1[3]);
        if (ga.act == 2) *reinterpret_cast<uint4*>(ga.o16 + ((long)(col >> 4) * MTOK + row) * 16 + (col & 15)) = o;
        else *reinterpret_cast<uint4*>(ga.o16 + (long)row * ga.ldo + col) = o;
      }
    } else if (EPI == EPI_S) {
      UNR for (int ai = 0; ai < 2; ++ai) UNR for (int bj = 0; bj < 2; ++bj) UNR for (int m = 0; m < MT; ++m) {
        int R = brow + ai * HROWS + wr * MROWS + m * 16 + fr, col = bj * HALF + wc * 32 + fq * 8;
        f32x4 a0 = acc[ai][bj][m][0], a1 = acc[ai][bj][m][1];
        uint4 o; o.x = pack2(a0[0], a0[1]); o.y = pack2(a0[2], a0[3]); o.z = pack2(a1[0], a1[1]); o.w = pack2(a1[2], a1[3]);
        *reinterpret_cast<uint4*>(ga.o16 + ((long)grp * NCHR + R) * 256 + col) = o;
      }
    } else if (EPI == EPI_Y) {
      UNR for (int ai = 0; ai < 2; ++ai) UNR for (int bj = 0; bj < 2; ++bj) UNR for (int m = 0; m < MT; ++m) {
        int R = brow + ai * HROWS + wr * MROWS + m * 16 + fr, tau = bj * 8 + wc * 2 + (fq >> 1), ch = (fq & 1) * 8;
        f32x4 a0 = acc[ai][bj][m][0], a1 = acc[ai][bj][m][1]; uint4 o;
        o.x = pack2(gelu_tanh(a0[0]), gelu_tanh(a0[1])); o.y = pack2(gelu_tanh(a0[2]), gelu_tanh(a0[3]));
        o.z = pack2(gelu_tanh(a1[0]), gelu_tanh(a1[1])); o.w = pack2(gelu_tanh(a1[2]), gelu_tanh(a1[3]));
        *reinterpret_cast<uint4*>(ga.o16 + ((long)R * 16 + tau) * 1024 + grp * 16 + ch) = o;
      }
    } else {
      u16* Q = (u16*)(p.ws + OFF_R1 + R1_Q); u16* KB = (u16*)(p.ws + OFF_R1 + R1_KB); u16* VT = (u16*)(p.ws + OFF_R1 + R1_VT);
      const float* rope = (const float*)(p.ws + OFF_ROPE);
      const bool is_ctx = brow < MCTX;
      if (pn < 4) {
        UNR for (int ai = 0; ai < 2; ++ai) UNR for (int bj = 0; bj < 2; ++bj) UNR for (int m = 0; m < MT; ++m) {
          int row = brow + ai * HROWS + wr * MROWS + m * 16 + fr, col = bcol + bj * HALF + wc * 32 + fq * 8;
          f32x4 a0 = acc[ai][bj][m][0], a1 = acc[ai][bj][m][1];
          uint4 o; o.x = pack2(a0[0], a0[1]); o.y = pack2(a0[2], a0[3]); o.z = pack2(a1[0], a1[1]); o.w = pack2(a1[2], a1[3]);
          *reinterpret_cast<uint4*>(Q + (long)row * 1024 + col) = o;
        }
      } else if (pn == 4) {
        UNR for (int ai = 0; ai < 2; ++ai) UNR for (int bj = 0; bj < 2; ++bj) UNR for (int m = 0; m < MT; ++m) {
          int row = brow + ai * HROWS + wr * MROWS + m * 16 + fr, c0 = bj * HALF + wc * 32 + fq * 4;
          f32x4 x1 = acc[ai][bj][m][0], x2 = acc[ai][bj][m][1];
          if (is_ctx) {
            int b = row >> 8, t = row & 255;
            float* ck = p.out + OUT_CK + ((long)(b * 2 + ga.attn_a) * 256 + t) * 256;
            *reinterpret_cast<float4*>(ck + c0) = make_float4(x1[0], x1[1], x1[2], x1[3]);
            *reinterpret_cast<float4*>(ck + c0 + 16) = make_float4(x2[0], x2[1], x2[2], x2[3]);
          } else {
            int t = (row - MCTX) & 4095; int pos = (wc & 1) ? (t & 63) : (t >> 6);
            const float* cs = rope + (pos * 16 + fq * 4) * 2;
            float4 cs01 = *reinterpret_cast<const float4*>(cs), cs23 = *reinterpret_cast<const float4*>(cs + 4);
            float cc[4] = {cs01.x, cs01.z, cs23.x, cs23.z}, ss[4] = {cs01.y, cs01.w, cs23.y, cs23.w};
            UNR for (int j = 0; j < 4; ++j) { float a = x1[j], b2 = x2[j]; x1[j] = a * cc[j] - b2 * ss[j]; x2[j] = a * ss[j] + b2 * cc[j]; }
          }
          uint2 o1, o2; o1.x = pack2(x1[0], x1[1]); o1.y = pack2(x1[2], x1[3]); o2.x = pack2(x2[0], x2[1]); o2.y = pack2(x2[2], x2[3]);
          *reinterpret_cast<uint2*>(KB + (long)row * 256 + c0) = o1;
          *reinterpret_cast<uint2*>(KB + (long)row * 256 + c0 + 16) = o2;
        }
      } else {
        UNR for (int ai = 0; ai < 2; ++ai) UNR for (int bj = 0; bj < 2; ++bj) UNR for (int m = 0; m < MT; ++m) UNR for (int n = 0; n < 2; ++n) {
          int row = brow + ai * HROWS + wr * MROWS + m * 16 + fr, c0 = bj * HALF + wc * 32 + n * 16 + fq * 4;
          f32x4 a = acc[ai][bj][m][n];
          if (is_ctx) {
            int b = row >> 8, t = row & 255;
            float* cv = p.out + OUT_CV + ((long)(b * 2 + ga.attn_a) * 256 + t) * 256;
            *reinterpret_cast<float4*>(cv + c0) = make_float4(a[0], a[1], a[2], a[3]);
            u16* vt = VT + ((long)b * 256 + c0) * 256 + t;
            UNR for (int j = 0; j < 4; ++j) vt[j * 256] = f2bf(a[j]);
          } else {
            int b = (row - MCTX) >> 12, t = (row - MCTX) & 4095;
            u16* vt = VT + (long)16 * 256 * 256 + ((long)b * 256 + c0) * 4096 + t;
            UNR for (int j = 0; j < 4; ++j) vt[j * 4096] = f2bf(a[j]);
          }
        }
      }
    }
  }
}

template <int AMODE, int EPI, int MT = 4>
DI void gemm_phase(const Params& p, const GemmArgs& ga) {
  constexpr int MROWS = MT * 16, HROWS = 2 * MROWS, TROWS = 2 * HROWS;
  extern __shared__ __attribute__((aligned(16))) __hip_bfloat16 shm[];
#define SA(b, h) (shm + ((b) * 2 + (h)) * HT)
#define SB(b, h) (shm + (4 + (b) * 2 + (h)) * HT)
#define GLDS(src, dst) __builtin_amdgcn_global_load_lds((const unsigned*)(src), (unsigned*)(dst), 16, 0, 0)
#define STA(P, h, kt) do { const char* _s = (const char*)a_base(h, kt); \
    GLDS(_s + (size_t)offA, (char*)(P) + wsid * 1024); GLDS(_s + skipA + (size_t)offA, (char*)(P) + wsid * 1024 + 8192); } while (0)
#define STB(P, h, kt) do { const char* _s = (const char*)(T.Bb + (long)((h) * HALF) * K + (long)(kt) * BK); \
    GLDS(_s + (size_t)offB, (char*)(P) + wsid * 1024); GLDS(_s + skipB + (size_t)offB, (char*)(P) + wsid * 1024 + 8192); } while (0)
#define LDA(dst, b, h) UNR for (int m = 0; m < MT; ++m) UNR for (int k = 0; k < 2; ++k) \
    dst[m][k] = *reinterpret_cast<const bf16x8*>((char*)SA(b, h) + lds_byte(wr * MROWS + m * 16 + fr, k * 32 + fq * 8))
#define LDB(dst, b, h) UNR for (int n = 0; n < 2; ++n) UNR for (int k = 0; k < 2; ++k) \
    dst[n][k] = *reinterpret_cast<const bf16x8*>((char*)SB(b, h) + lds_byte(wc * 32 + n * 16 + fr, k * 32 + fq * 8))
#define MMA(ai, bj, Af, Bf) do { __builtin_amdgcn_s_setprio(1); \
    UNR for (int m = 0; m < MT; ++m) UNR for (int n = 0; n < 2; ++n) UNR for (int k = 0; k < 2; ++k) \
      acc[ai][bj][m][n] = __builtin_amdgcn_mfma_f32_16x16x32_bf16(Bf[n][k], Af[m][k], acc[ai][bj][m][n], 0, 0, 0); \
    __builtin_amdgcn_s_setprio(0); } while (0)
#define WAIT_V(n) asm volatile("s_waitcnt vmcnt(" #n ")" ::: "memory")
#define WAIT_L(n) asm volatile("s_waitcnt lgkmcnt(" #n ")" ::: "memory")
#define BAR __builtin_amdgcn_s_barrier()
#define SCHED __builtin_amdgcn_sched_barrier(0)

  const int K = ga.K, nM = ga.nM, nN = ga.nN;
  const int ntiles = (AMODE == 0) ? nM * nN : 9 * 64;
  const int tidx = opaque_tid();
  const int wsid = __builtin_amdgcn_readfirstlane((int)threadIdx.x >> 6);
  const int wid = tidx >> 6, lane = tidx & 63, wr = wid >> 2, wc = wid & 3, fr = lane & 15, fq = lane >> 4;
  unsigned offA, offB;
  {
    int R0, C0;
    stage_rc(tidx * 16, R0, C0);
    if (AMODE == 0) offA = (R0 * ga.lda + C0) * 2;
    else offA = (R0 * 256 + C0) * 2;
    offB = (R0 * K + C0) * 2;
  }
  const long skipA = AMODE == 0 ? (long)ga.lda * 128 : 64L * 256 * 2; const long skipB = (long)K * 128;
  const int nt_total = K / BK;
  const int G = gridDim.x;
  int nfull = ntiles, sp = 1;
  if (EPI == EPI_RES) {
    int rem = ntiles % G, pairs = nt_total >> 1;
    if (SPLITK_TAIL && rem) { if (rem * 4 <= G && pairs >= 8) sp = 4; else if (rem * 2 <= G && pairs >= 4) sp = 2; }
    if (sp > 1) nfull = ntiles - rem;
  }
  const int nunits = nfull + (ntiles - nfull) * sp;
  int vb = blockIdx.x;
  if ((G & 7) == 0) vb = (blockIdx.x & 7) * (G >> 3) + (blockIdx.x >> 3);

  struct GTile { int brow, bcol, pn, grp, nt, split; const u16 *Ab, *Ab2, *Bb; };
  auto decode = [&](int u, GTile& T) {
    int tile = u, kt0 = 0; T.nt = nt_total; T.split = 0;
    if (EPI == EPI_RES && u >= nfull) {
      int v = u - nfull, part = v % sp; tile = nfull + v / sp;
      int pairs = nt_total >> 1, qq = pairs / sp, rr = pairs % sp;
      kt0 = 2 * (part * qq + min(part, rr)); T.nt = 2 * (qq + (part < rr ? 1 : 0)); T.split = 1;
    }
    int pm, pn, grp = 0;
    if (AMODE == 0) {
      const int WGM = 8;
      int nig = WGM * nN, gid = tile / nig, fm = gid * WGM, gsz = min(nM - fm, WGM);
      pm = fm + ((tile % nig) % gsz); pn = (tile % nig) / gsz;
    } else { grp = tile / 9; pm = tile % 9; pn = 0; }
    T.brow = pm * TROWS; T.bcol = pn * BM; T.pn = pn; T.grp = grp;
    if (AMODE == 2) T.nt = 4;
    if (AMODE == 0) { T.Ab = ga.A + (long)T.brow * ga.lda + (long)kt0 * BK; T.Ab2 = nullptr; T.Bb = ga.Bt + (long)T.bcol * K + (long)kt0 * BK; }
    else { T.Ab = ga.A + ((long)grp * NCHR + T.brow) * 256; T.Ab2 = ga.A2 + ((long)grp * NCHR + T.brow) * 256; T.Bb = ga.Bt + (long)grp * 256 * K; }
  };
  GTile T, TN;
  auto a_base = [&](int h, int kt) -> const u16* {
    if (AMODE == 0) return T.Ab + (long)(h * HROWS) * ga.lda + (long)kt * BK;
    return T.Ab + (long)(h * HROWS) * 256 + kt * BK;
  };
#define PROLOGUE1() do { STB(SB(0, 0), 0, 0); STA(SA(0, 0), 0, 0); STB(SB(0, 1), 1, 0); STA(SA(0, 1), 1, 0); } while (0)
  int u = vb;
  if (u < nunits) { decode(u, T); PROLOGUE1(); }
  while (u < nunits) {
    const int nt = T.nt;
    f32x4 acc[2][2][MT][2] = {};
    bf16x8 At[MT][2], B0[2][2], B1[2][2];
#pragma unroll 1
    for (int pass = 0; pass < (AMODE == 2 ? 2 : 1); ++pass) {
    if (AMODE == 2 && pass == 1) { T.Ab = T.Ab2; T.Bb += 4 * BK; PROLOGUE1(); }
    if (wr == 1) BAR;
    WAIT_V(4); BAR;
    STB(SB(1, 0), 0, 1); STA(SA(1, 0), 0, 1); STB(SB(1, 1), 1, 1);
    WAIT_V(6); BAR;
    for (int t = 0; t < nt - 2; t += 2) {
      LDB(B0, 0, 0); SCHED; LDA(At, 0, 0); STA(SA(1, 1), 1, t + 1);
      WAIT_L(8); BAR; WAIT_L(0); MMA(0, 0, At, B0); BAR; SCHED;
      LDB(B1, 0, 1); STB(SB(0, 0), 0, t + 2);
      BAR; WAIT_L(0); MMA(0, 1, At, B1); BAR;
      LDA(At, 0, 1); STA(SA(0, 0), 0, t + 2);
      BAR; WAIT_L(0); MMA(1, 0, At, B0); BAR; SCHED;
      STB(SB(0, 1), 1, t + 2);
      WAIT_V(6); BAR; MMA(1, 1, At, B1); BAR;
      LDB(B0, 1, 0); SCHED; LDA(At, 1, 0); STA(SA(0, 1), 1, t + 2);
      WAIT_L(8); BAR; WAIT_L(0); MMA(0, 0, At, B0); BAR; SCHED;
      LDB(B1, 1, 1); STB(SB(1, 0), 0, t + 3);
      BAR; WAIT_L(0); MMA(0, 1, At, B1); BAR;
      LDA(At, 1, 1); STA(SA(1, 0), 0, t + 3);
      BAR; WAIT_L(0); MMA(1, 0, At, B0); BAR; SCHED;
      STB(SB(1, 1), 1, t + 3);
      WAIT_V(6); BAR; MMA(1, 1, At, B1); BAR;
    }
    { LDB(B0, 0, 0); LDA(At, 0, 0); STA(SA(1, 1), 1, nt - 1);
      BAR; WAIT_L(0); MMA(0, 0, At, B0); BAR;
      LDB(B1, 0, 1); BAR; WAIT_L(0); MMA(0, 1, At, B1); BAR;
      LDA(At, 0, 1); WAIT_V(4); BAR; WAIT_L(0); MMA(1, 0, At, B0); MMA(1, 1, At, B1); BAR; }
    { LDB(B0, 1, 0); LDA(At, 1, 0); WAIT_V(2); BAR; WAIT_L(0); MMA(0, 0, At, B0); BAR;
      LDB(B1, 1, 1); WAIT_V(0); BAR; WAIT_L(0); MMA(0, 1, At, B1); BAR;
      LDA(At, 1, 1); BAR; WAIT_L(0); MMA(1, 0, At, B0); MMA(1, 1, At, B1); BAR; }
    if (wr == 0) BAR;
    }
    const int brow = T.brow, bcol = T.bcol, pn = T.pn, grp = T.grp, split = T.split;
    const int un = u + G;
    if (un < nunits) { decode(un, TN); T = TN; PROLOGUE1(); }
    u = un;

    gemm_epilogue<EPI, MT>(p, ga, acc, brow, bcol, pn, grp);
  }
  WAIT_V(0);
#undef SA
#undef SB
}

template <int EPI, int MT, int GMODE = 0>
DI void gemm_sp2(const Params& p, const GemmArgs& ga) {
  constexpr int MROWS = MT * 16, HROWS = 2 * MROWS, TROWS = 2 * HROWS;
  extern __shared__ __attribute__((aligned(16))) __hip_bfloat16 shm[];
#define XSA(b, h) ((char*)shm + ((b) * 2 + (h)) * (HT * 2))
#define XSB(b, h) ((char*)shm + (4 + (b) * 2 + (h)) * (HT * 2))
#define XGL(src, dst) __builtin_amdgcn_global_load_lds((const unsigned*)(src), (unsigned*)(dst), 16, 0, 0)
#define XSTA(P, base) do { const char* _s = (base); XGL(_s + (size_t)offA, (P) + wsid * 1024); XGL(_s + skipA + (size_t)offA, (P) + wsid * 1024 + 8192); } while (0)
#define XSTB(P, base) do { const char* _s = (base); XGL(_s + (size_t)offB, (P) + wsid * 1024); XGL(_s + skipB + (size_t)offB, (P) + wsid * 1024 + 8192); } while (0)
#define XLDA(dst, b, h) UNR for (int m = 0; m < MT; ++m) UNR for (int k = 0; k < 2; ++k) \
    dst[m][k] = *reinterpret_cast<const bf16x8*>(XSA(b, h) + lds_byte(wr * MROWS + m * 16 + fr, k * 32 + fq * 8))
#define XLDB(dst, b, h) UNR for (int n = 0; n < 2; ++n) UNR for (int k = 0; k < 2; ++k) \
    dst[n][k] = *reinterpret_cast<const bf16x8*>(XSB(b, h) + lds_byte(wc * 32 + n * 16 + fr, k * 32 + fq * 8))
#define XMMA(ai, bj, Af, Bf) do { __builtin_amdgcn_s_setprio(1); \
    UNR for (int m = 0; m < MT; ++m) UNR for (int n = 0; n < 2; ++n) UNR for (int k = 0; k < 2; ++k) \
      acc[ai][bj][m][n] = __builtin_amdgcn_mfma_f32_16x16x32_bf16(Bf[n][k], Af[m][k], acc[ai][bj][m][n], 0, 0, 0); \
    __builtin_amdgcn_s_setprio(0); } while (0)
  constexpr int NPASS = GMODE == 2 ? 2 : 1;
  const int K = ga.K, nM = ga.nM, nN = ga.nN, nt = GMODE ? 4 : K / BK, G = gridDim.x;
  const int sub = ga.sub > 0 ? ga.sub : 1;
  const int nunits = GMODE ? 64 * nM : (ga.ucount > 0 ? ga.ucount : nM * nN);
  const int lda = GMODE ? 256 : ga.lda;
  const int tidx = opaque_tid();
  const int wsid = __builtin_amdgcn_readfirstlane((int)threadIdx.x >> 6);
  const int wid = tidx >> 6, lane = tidx & 63, wr = wid >> 2, wc = wid & 3, fr = lane & 15, fq = lane >> 4;
  unsigned offA, offB;
  { int R0, C0; stage_rc(tidx * 16, R0, C0); offA = (R0 * lda + C0) * 2; offB = (R0 * K + C0) * 2; }
  const long skipA = (long)lda * 128, skipB = (long)K * 128;
  const long hstepA = (long)HROWS * lda * 2, hstepB = (long)HALF * K * 2;
  const long kstep = BK * 2;
  int vb = blockIdx.x;
  if ((G & 7) == 0) vb = (blockIdx.x & 7) * (G >> 3) + (blockIdx.x >> 3);
  struct XU { int brow, bcol, pn, grp; const char *cA, *cB; };
  auto decode = [&](int tile, int pass, XU& T) {
    if (GMODE == 0) {
      const int WGM = 8;
      const int part = tile % sub; tile = ga.tbase + tile / sub;
      int nig = WGM * nN, gid = tile / nig, fm = gid * WGM, gsz = min(nM - fm, WGM);
      int pm = fm + ((tile % nig) % gsz), pn = (tile % nig) / gsz;
      if (ga.rev) pm = nM - 1 - pm;
      T.brow = pm * (TROWS * sub) + part * TROWS; T.bcol = pn * BM; T.pn = pn; T.grp = 0;
      T.cA = (const char*)ga.A + (long)T.brow * lda * 2; T.cB = (const char*)ga.Bt + (long)T.bcol * K * 2;
    } else {
      int grp = tile / nM, pm = tile % nM;
      T.brow = pm * TROWS; T.bcol = 0; T.pn = 0; T.grp = grp;
      T.cA = (const char*)(pass == 0 ? ga.A : ga.A2) + ((long)grp * NCHR + T.brow) * 256 * 2;
      T.cB = (const char*)ga.Bt + ((long)grp * 256 * K + pass * 256) * 2;
    }
  };
  int u = vb, pass = 0;
  if (u >= nunits) return;
  XU cur, nxt;
  decode(u, 0, cur);
  const char* cA = cur.cA; const char* cB = cur.cB;
  f32x4 acc[2][2][MT][2] = {};
  bf16x8 At[MT][2], B0[2][2], B1[2][2];
  XSTB(XSB(0, 0), cB); XSTB(XSB(0, 1), cB + hstepB); XSTA(XSA(0, 0), cA); XSTA(XSA(0, 1), cA + hstepA);
  if (wr == 1) BAR;
  WAIT_V(2); BAR;
  XSTB(XSB(1, 0), cB + kstep); XSTA(XSA(1, 0), cA + kstep); XSTB(XSB(1, 1), cB + hstepB + kstep);
  WAIT_V(6); BAR;
  for (;;) {
    int un = u, npass = pass + 1;
    if (npass == NPASS) { npass = 0; un = u + G; }
    const bool has_next = un < nunits, fin = (pass == NPASS - 1);
    if (has_next) decode(un, npass, nxt);
    const char* nA = has_next ? nxt.cA : cA; const char* nB = has_next ? nxt.cB : cB;
    for (int t = 0; t < nt; t += 2) {
      const bool last = (t == nt - 2);
      const char* a1 = cA + (long)(t + 1) * kstep;
      const char* a2 = last ? nA : cA + (long)(t + 2) * kstep; const char* b2 = last ? nB : cB + (long)(t + 2) * kstep;
      const char* a3 = a2 + kstep; const char* b3 = b2 + kstep;
      XLDB(B0, 0, 0); XLDB(B1, 0, 1); SCHED; XLDA(At, 0, 0); XSTA(XSA(1, 1), a1 + hstepA);
      WAIT_V(8); WAIT_L(0); BAR; XMMA(0, 0, At, B0); XMMA(0, 1, At, B1); BAR; SCHED;
      XLDA(At, 0, 1); XSTB(XSB(0, 0), b2); XSTB(XSB(0, 1), b2 + hstepB); XSTA(XSA(0, 0), a2);
      WAIT_V(8); WAIT_L(0); BAR; XMMA(1, 0, At, B0); XMMA(1, 1, At, B1); BAR; SCHED;
      XLDB(B0, 1, 0); XLDB(B1, 1, 1); SCHED; XLDA(At, 1, 0); XSTA(XSA(0, 1), a2 + hstepA);
      WAIT_V(8); WAIT_L(0); BAR; XMMA(0, 0, At, B0); XMMA(0, 1, At, B1); BAR; SCHED;
      XLDA(At, 1, 1); XSTB(XSB(1, 0), b3); XSTB(XSB(1, 1), b3 + hstepB); XSTA(XSA(1, 0), a3);
      WAIT_V(8); WAIT_L(0); BAR; XMMA(1, 0, At, B0); XMMA(1, 1, At, B1); BAR; SCHED;
    }
    if (fin) {
      if (wr == 0) BAR;
      gemm_epilogue<EPI, MT>(p, ga, acc, cur.brow, cur.bcol, cur.pn, cur.grp);
    }
    if (!has_next) break;
    if (fin) { UNR for (int a = 0; a < 2; ++a) UNR for (int b = 0; b < 2; ++b) UNR for (int m = 0; m < MT; ++m) UNR for (int n = 0; n < 2; ++n) acc[a][b][m][n] = (f32x4){0.f, 0.f, 0.f, 0.f}; }
    cur = nxt; cA = nA; cB = nB; u = un; pass = npass;
    if (fin && wr == 1) BAR;
  }
  WAIT_V(0);
  BAR;
#undef XSA
#undef XSB
}

#define MFMA32(a, b, c) __builtin_amdgcn_mfma_f32_32x32x16_bf16((a), (b), (c), 0, 0, 0)

struct KVTile { bf16x8 k[4]; bf16x8 v[2][2]; };
constexpr int AT_ROW = 144, AT_KB = 64 * AT_ROW, AT_STAGE = 2 * AT_KB;

DI void read_kv(KVTile& t, const char* kbuf, const char* vbuf, int sb, int l32, int h) {
  const int kperm = (l32 & ~12) | ((l32 & 4) << 1) | ((l32 & 8) >> 1);
  const char* kp = kbuf + (sb * 32 + kperm) * AT_ROW + h * 64;
#pragma unroll
  for (int kk = 0; kk < 4; ++kk) t.k[kk] = *reinterpret_cast<const bf16x8*>(kp + kk * 16);
#pragma unroll
  for (int dt = 0; dt < 2; ++dt)
#pragma unroll
    for (int k2 = 0; k2 < 2; ++k2)
      t.v[dt][k2] = *reinterpret_cast<const bf16x8*>(vbuf + (dt * 32 + l32) * AT_ROW + sb * 64 + k2 * 32 + h * 16);
}

template <bool MASK>
DI void attn_tile(const KVTile& t, const bf16x8 (&q)[2][4], f32x16 (&O)[2][2], float (&mrow)[2], float (&lrow)[2],
                  int k0, int q0w, int l32, int h, float c1) {
#pragma unroll
  for (int qt = 0; qt < 2; ++qt) {
    const int q0t = q0w + qt * 32;
    bool need_mask = false;
    if (MASK) {
      if (k0 + 31 < q0t - 128 || k0 > q0t + 31 + 128) continue;
      need_mask = (q0t + 31 - k0 > 128) || (k0 + 31 - q0t > 128);
    }
    f32x16 S;
#pragma unroll
    for (int i = 0; i < 16; ++i) S[i] = 0.f;
#pragma unroll
    for (int kk = 0; kk < 4; ++kk) S = MFMA32(t.k[kk], q[qt][kk], S);
    if (MASK && need_mask) {
      const int base = q0t + l32 - k0 - 8 * h + 128;
#pragma unroll
      for (int r = 0; r < 16; ++r) {
        unsigned d = (unsigned)(base - (16 * (r >> 3) + (r & 7)));
        if (d > 256u) S[r] = -1.0e30f;
      }
    }
    float mx = S[0];
#pragma unroll
    for (int r = 1; r < 16; ++r) mx = fmaxf(mx, S[r]);
    mx = xhalf_max(mx);
    const float mold = mrow[qt];
    const float cand = mx * c1;
    const float mnew = cand > mold + 8.f ? cand : mold;
    mrow[qt] = mnew;
    float rs = 0.f;
#pragma unroll
    for (int r = 0; r < 16; ++r) { float pv = __builtin_amdgcn_exp2f(fmaf(S[r], c1, -mnew)); S[r] = pv; rs += pv; }
    rs = xhalf_sum(rs);
    if (__ballot(mnew != mold) != 0) {
      const float alpha = __builtin_amdgcn_exp2f(mold - mnew);
      lrow[qt] *= alpha;
#pragma unroll
      for (int dt = 0; dt < 2; ++dt)
#pragma unroll
        for (int r = 0; r < 16; ++r) O[qt][dt][r] *= alpha;
    }
    lrow[qt] += rs;
    bf16x8 pk[2];
#pragma unroll
    for (int k2 = 0; k2 < 2; ++k2) {
      uint4 u;
      u.x = pack2(S[8 * k2 + 0], S[8 * k2 + 1]); u.y = pack2(S[8 * k2 + 2], S[8 * k2 + 3]);
      u.z = pack2(S[8 * k2 + 4], S[8 * k2 + 5]); u.w = pack2(S[8 * k2 + 6], S[8 * k2 + 7]);
      pk[k2] = __builtin_bit_cast(bf16x8, u);
    }
#pragma unroll
    for (int dt = 0; dt < 2; ++dt)
#pragma unroll
      for (int k2 = 0; k2 < 2; ++k2) O[qt][dt] = MFMA32(t.v[dt][k2], pk[k2], O[qt][dt]);
  }
}

DI void attn_phase(const Params& p, int a) {
  extern __shared__ __attribute__((aligned(16))) __hip_bfloat16 shm[];
  char* lds = (char*)shm;
  const u16* Q = (const u16*)(p.ws + OFF_R1 + R1_Q); const u16* KB = (const u16*)(p.ws + OFF_R1 + R1_KB);
  const u16* VT = (const u16*)(p.ws + OFF_R1 + R1_VT); u16* Og = (u16*)(p.ws + OFF_R1 + R1_O);
  const u16* KC = (const u16*)(p.ws + OFF_KC); const u16* VTC = (const u16*)(p.ws + OFF_VTC);
  const float* rope = (const float*)(p.ws + OFF_ROPE);
  const int tidx = opaque_tid();
  const int wid = tidx >> 6, lane = tidx & 63, l32 = lane & 31, h = lane >> 5;
  const int grow = tidx >> 3, gc = tidx & 7;
  const float LOG2E = 1.4426950408889634f, c1 = 0.125f * LOG2E;
  for (int it = blockIdx.x; it < 1152; it += gridDim.x) {
    const bool lat = it < 1024;
    int seq, qblk, kvh;
    if (lat) { kvh = it & 3; qblk = (it >> 2) & 31; seq = it >> 7; } else { int j = it - 1024; kvh = j & 3; qblk = (j >> 2) & 1; seq = j >> 3; }
    const int head = kvh * 4 + (wid >> 1);
    const int qb0 = qblk * 128, q0 = qb0 + (wid & 1) * 64;
    const long rowbase = lat ? (long)MCTX + (long)seq * 4096 : (long)seq * 256;
    const u16 *KbA, *VbA; long vsA; int nA;
    if (lat) { KbA = KC + ((long)(seq * 2 + a) * 512) * 256 + kvh * 64; VbA = VTC + ((long)(seq * 2 + a) * 256 + kvh * 64) * 512; vsA = 512; nA = 8; }
    else { KbA = KB + rowbase * 256 + kvh * 64; VbA = VT + ((long)seq * 256 + kvh * 64) * 256; vsA = 256; nA = 4; }
    const u16* KbB = KB + rowbase * 256 + kvh * 64;
    const u16* VbB = VT + (long)16 * 256 * 256 + ((long)seq * 256 + kvh * 64) * 4096;
    const int m0 = qblk == 0 ? 2 : 0, m1 = lat ? (qblk == 31 ? 4 : 6) : 0;
    const int nS = nA + (lat ? m1 - m0 : 0);
    auto issue = [&](int j, uint4& kreg, uint4& vreg) {
      if (j < nA) {
        int key0 = j * 64;
        kreg = *reinterpret_cast<const uint4*>(KbA + (long)(key0 + grow) * 256 + gc * 8);
        vreg = *reinterpret_cast<const uint4*>(VbA + (long)grow * vsA + key0 + gc * 8);
      } else {
        int key0 = qb0 - 128 + (j - nA + m0) * 64;
        kreg = *reinterpret_cast<const uint4*>(KbB + (long)(key0 + grow) * 256 + gc * 8);
        vreg = *reinterpret_cast<const uint4*>(VbB + (long)grow * 4096 + key0 + gc * 8);
      }
    };
    uint4 kreg, vreg;
    issue(0, kreg, vreg);
    bf16x8 q[2][4];
#pragma unroll
    for (int qt = 0; qt < 2; ++qt) {
      const uint4* qp = reinterpret_cast<const uint4*>(Q + (rowbase + q0 + qt * 32 + l32) * 1024 + head * 64 + h * 32);
#pragma unroll
      for (int kk = 0; kk < 4; ++kk) q[qt][kk] = __builtin_bit_cast(bf16x8, qp[kk]);
    }
    const float sk = p.sink[a * 16 + head] * LOG2E;
    float mrow[2] = {sk, sk}, lrow[2] = {1.f, 1.f};
    f32x16 O[2][2];
#pragma unroll
    for (int qt = 0; qt < 2; ++qt)
#pragma unroll
      for (int dt = 0; dt < 2; ++dt)
#pragma unroll
        for (int r = 0; r < 16; ++r) O[qt][dt][r] = 0.f;
    *reinterpret_cast<uint4*>(lds + grow * AT_ROW + gc * 16) = kreg;
    *reinterpret_cast<uint4*>(lds + AT_KB + grow * AT_ROW + gc * 16) = vreg;
    __syncthreads();
#define ATT_STAGE_BEGIN const char* kbuf = lds + (j & 1) * AT_STAGE; const char* vbuf = kbuf + AT_KB; if (j + 1 < nS) issue(j + 1, kreg, vreg);
#define ATT_STAGE_END if (j + 1 < nS) { char* nb = lds + ((j + 1) & 1) * AT_STAGE; \
        *reinterpret_cast<uint4*>(nb + grow * AT_ROW + gc * 16) = kreg; *reinterpret_cast<uint4*>(nb + AT_KB + grow * AT_ROW + gc * 16) = vreg; } \
      __syncthreads();
    for (int j = 0; j < nA; ++j) {
      ATT_STAGE_BEGIN
#pragma unroll 1
      for (int sb = 0; sb < 2; ++sb) {
        KVTile t; read_kv(t, kbuf, vbuf, sb, l32, h);
        attn_tile<false>(t, q, O, mrow, lrow, 0, 0, l32, h, c1);
      }
      ATT_STAGE_END
    }
    if (lat) {
#pragma unroll
      for (int qt = 0; qt < 2; ++qt) {
        int t = q0 + qt * 32 + l32; int pos = h ? (t & 63) : (t >> 6);
#pragma unroll
        for (int kk = 0; kk < 2; ++kk) {
          const float4* cs = reinterpret_cast<const float4*>(rope + (pos * 16 + kk * 8) * 2);
#pragma unroll
          for (int e2 = 0; e2 < 4; ++e2) {
            float4 c4 = cs[e2];
            float cA = c4.x, sA = c4.y, cB = c4.z, sB = c4.w;
            float x1 = bf2f((u16)q[qt][kk][2 * e2]), x2 = bf2f((u16)q[qt][kk + 2][2 * e2]);
            q[qt][kk][2 * e2] = (short)f2bf(x1 * cA - x2 * sA); q[qt][kk + 2][2 * e2] = (short)f2bf(x1 * sA + x2 * cA);
            x1 = bf2f((u16)q[qt][kk][2 * e2 + 1]); x2 = bf2f((u16)q[qt][kk + 2][2 * e2 + 1]);
            q[qt][kk][2 * e2 + 1] = (short)f2bf(x1 * cB - x2 * sB); q[qt][kk + 2][2 * e2 + 1] = (short)f2bf(x1 * sB + x2 * cB);
          }
        }
      }
      for (int j = nA; j < nS; ++j) {
        ATT_STAGE_BEGIN
        const int key0 = qb0 - 128 + (j - nA + m0) * 64;
#pragma unroll 1
        for (int sb = 0; sb < 2; ++sb) {
          const int k0 = key0 + sb * 32;
          if (k0 + 31 >= q0 - 128 && k0 <= q0 + 63 + 128) {
            KVTile t; read_kv(t, kbuf, vbuf, sb, l32, h);
            attn_tile<true>(t, q, O, mrow, lrow, k0, q0, l32, h, c1);
          }
        }
        ATT_STAGE_END
      }
    }
    {
      char* ost = lds + 40960 + wid * (64 * 144);
#pragma unroll
      for (int qt = 0; qt < 2; ++qt) {
        const float inv = __builtin_amdgcn_rcpf(lrow[qt]);
        char* orow = ost + (qt * 32 + l32) * 144 + 8 * h;
#pragma unroll
        for (int dt = 0; dt < 2; ++dt)
#pragma unroll
          for (int g4 = 0; g4 < 4; ++g4) {
            uint2 o; o.x = pack2(O[qt][dt][4 * g4] * inv, O[qt][dt][4 * g4 + 1] * inv);
            o.y = pack2(O[qt][dt][4 * g4 + 2] * inv, O[qt][dt][4 * g4 + 3] * inv);
            *reinterpret_cast<uint2*>(orow + dt * 64 + 16 * g4) = o;
          }
      }
      asm volatile("s_waitcnt lgkmcnt(0)" ::: "memory");
#pragma unroll
      for (int e = 0; e < 8; ++e) {
        const int gidx = lane + 64 * e, r = gidx >> 3, c = gidx & 7;
        uint4 v = *reinterpret_cast<const uint4*>(ost + r * 144 + c * 16);
        *reinterpret_cast<uint4*>(Og + (rowbase + q0 + r) * 1024 + head * 64 + c * 8) = v;
      }
      asm volatile("s_waitcnt lgkmcnt(0)" ::: "memory");
    }
  }
}

DI void row_phase(const Params& p, int mode, int ln_layer, int ln_idx, int mod_layer, int mod_idx) {
  const u16* X = (const u16*)(p.ws + OFF_X); u16* H = (u16*)(p.ws + OFF_H);
  const int tidx = opaque_tid();
  const int lane = tidx & 63, gw = blockIdx.x * 8 + (tidx >> 6), nw = gridDim.x * 8;
  float4 g4[4], b4[4];
  if (mode != 0) {
    const float* g = p.ln_g + (ln_layer * 2 + ln_idx) * 1024; const float* b = p.ln_b + (ln_layer * 2 + ln_idx) * 1024;
    UNR for (int j = 0; j < 4; ++j) { g4[j] = *reinterpret_cast<const float4*>(g + j * 256 + lane * 4); b4[j] = *reinterpret_cast<const float4*>(b + j * 256 + lane * 4); }
  }
  for (int row0 = gw * 2; row0 < MTOK; row0 += nw * 2) {
    float4 v[2][4];
    UNR for (int rr = 0; rr < 2; ++rr) {
      const int row = row0 + rr;
      if (mode == 0) {
        const float* src = row < MCTX ? p.x_prompt + (long)row * D : p.x_sample + (long)(row - MCTX) * D;
        UNR for (int j = 0; j < 4; ++j) v[rr][j] = nt_load_f4(src + j * 256 + lane * 4);
      } else {
        const u16* src = X + (long)row * D;
        UNR for (int j = 0; j < 4; ++j) {
          uint2 raw = nt_load_u2(src + j * 256 + lane * 4);
          v[rr][j] = make_float4(__uint_as_float(raw.x << 16), __uint_as_float(raw.x & 0xffff0000u), __uint_as_float(raw.y << 16), __uint_as_float(raw.y & 0xffff0000u));
        }
      }
    }
    UNR for (int rr = 0; rr < 2; ++rr) {
      const int row = row0 + rr;
      if (mode != 0) {
        float s = 0.f;
        UNR for (int j = 0; j < 4; ++j) s += v[rr][j].x + v[rr][j].y + v[rr][j].z + v[rr][j].w;
        float mu = wave_sum(s, lane) * (1.f / 1024.f);
        float q = 0.f;
        UNR for (int j = 0; j < 4; ++j) { v[rr][j].x -= mu; v[rr][j].y -= mu; v[rr][j].z -= mu; v[rr][j].w -= mu; q += v[rr][j].x * v[rr][j].x + v[rr][j].y * v[rr][j].y + v[rr][j].z * v[rr][j].z + v[rr][j].w * v[rr][j].w; }
        float rstd = rsqrtf(wave_sum(q, lane) * (1.f / 1024.f) + LN_EPS);
        if (mode == 1 && lane == 0) *reinterpret_cast<float2*>((float*)(p.ws + OFF_STATS) + (long)row * 2) = make_float2(mu, rstd);
        UNR for (int j = 0; j < 4; ++j) {
          v[rr][j].x = v[rr][j].x * rstd * g4[j].x + b4[j].x; v[rr][j].y = v[rr][j].y * rstd * g4[j].y + b4[j].y;
          v[rr][j].z = v[rr][j].z * rstd * g4[j].z + b4[j].z; v[rr][j].w = v[rr][j].w * rstd * g4[j].w + b4[j].w;
        }
      }
      if (mode == 2) {
        UNR for (int j = 0; j < 4; ++j) nt_store_f4(p.out + (long)row * D + j * 256 + lane * 4, v[rr][j]);
      } else {
        const int cond = cond_of_row(row);
        const float* sh = mods_ptr(p, mod_layer, cond, mod_idx); const float* sc = mods_ptr(p, mod_layer, cond, mod_idx + 1);
        UNR for (int j = 0; j < 4; ++j) {
          float4 s4 = *reinterpret_cast<const float4*>(sh + j * 256 + lane * 4), c4 = *reinterpret_cast<const float4*>(sc + j * 256 + lane * 4);
          uint2 o; o.x = pack2(v[rr][j].x * (1.f + c4.x) + s4.x, v[rr][j].y * (1.f + c4.y) + s4.y);
          o.y = pack2(v[rr][j].z * (1.f + c4.z) + s4.z, v[rr][j].w * (1.f + c4.w) + s4.w);
          *reinterpret_cast<uint2*>(H + (long)row * D + j * 256 + lane * 4) = o;
        }
      }
    }
  }
}

DI int prow(int n) { int a = n & 31; return (n & ~31) + ((a >> 2) & 1) * 16 + (a >> 3) * 4 + (a & 3); }
DI void sincos_red(float ang, float& s, float& c) {
  float n = rintf(ang * 0.15915494309189535f);
  float r = fmaf(-n, 6.2831854820251465f, ang);
  r = fmaf(-n, -1.7484555e-7f, r);
  s = __sinf(r); c = __cosf(r);
}

DI void ssm_prep(const Params& p, int s) {
  extern __shared__ __attribute__((aligned(16))) __hip_bfloat16 shm[];
  float* L = (float*)shm;
  float* ap_re = L;
  float* ap_im = ap_re + 2176;
  float* bb_re = ap_im + 2176;
  float* bb_im = bb_re + 2048;
  float* cc_re = bb_im + 2048;
  float* cc_im = cc_re + 2048;
  float* kmat = cc_im + 2048;
  u16* Pt = (u16*)(p.ws + OFF_PT); u16* Tt = (u16*)(p.ws + OFF_TT);
  const int tid = opaque_tid();
  for (int it = blockIdx.x; it < 256; it += gridDim.x) {
    const int g = it >> 2, qr = it & 3;
    __syncthreads();
    if (tid < 128) {
      int dir = tid >> 6, pp = tid & 63;
      long li = ((long)(s * 2 + dir) * 64 + g) * 64 + pp;
      float lr = p.lam_re[li], lim = p.lam_im[li];
      float dt = __expf(p.log_dt[(s * 2 + dir) * 64 + g]);
      for (int j = 0; j <= 16; ++j) {
        float mag = __expf((float)j * lr * dt), sn, cs;
        sincos_red((float)j * lim * dt, sn, cs);
        ap_re[(dir * 64 + pp) * 17 + j] = mag * cs; ap_im[(dir * 64 + pp) * 17 + j] = mag * sn;
      }
      float ar = ap_re[(dir * 64 + pp) * 17 + 1], ai = ap_im[(dir * 64 + pp) * 17 + 1];
      float den = lr * lr + lim * lim, nr = ar - 1.f, ni = ai;
      float cr = (nr * lr + ni * lim) / den, ci = (ni * lr - nr * lim) / den;
      for (int m = 0; m < 16; ++m) {
        float br = p.b_re[li * 16 + m], bi = p.b_im[li * 16 + m];
        bb_re[(dir * 64 + pp) * 16 + m] = cr * br - ci * bi; bb_im[(dir * 64 + pp) * 16 + m] = cr * bi + ci * br;
      }
    }
    for (int i = tid; i < 2048; i += 512) {
      int dir = i >> 10, r = i & 1023;
      long ci = ((long)(s * 2 + dir) * 64 + g) * 1024 + r;
      cc_re[i] = p.c_re[ci]; cc_im[i] = p.c_im[ci];
    }
    __syncthreads();
    {
      int dir = tid >> 8, j = (tid >> 4) & 15, m = tid & 15;
      float acc[16];
#pragma unroll
      for (int i = 0; i < 16; ++i) acc[i] = 0.f;
      for (int pp = 0; pp < 64; ++pp) {
        float cr = cc_re[(dir * 16 + m) * 64 + pp], ci = cc_im[(dir * 16 + m) * 64 + pp];
        float ar = ap_re[(dir * 64 + pp) * 17 + j], ai = ap_im[(dir * 64 + pp) * 17 + j];
        float xr = cr * ar - ci * ai, xi = cr * ai + ci * ar;
#pragma unroll
        for (int i = 0; i < 16; ++i) acc[i] += xr * bb_re[(dir * 64 + pp) * 16 + i] - xi * bb_im[(dir * 64 + pp) * 16 + i];
      }
#pragma unroll
      for (int i = 0; i < 16; ++i) kmat[((dir * 16 + j) * 16 + m) * 16 + i] = acc[i];
    }
    __syncthreads();
    for (int gi = tid; gi < 64 * 64; gi += 512) {
      int n = qr * 64 + (gi >> 6), k0 = (gi & 63) * 8, tau = n >> 4, m = n & 15;
      float v[8];
      if (k0 < 256) {
        int sg = k0 >> 4, mp0 = k0 & 15;
#pragma unroll
        for (int e = 0; e < 8; ++e) {
          int mp = mp0 + e; float x = 0.f;
          if (sg <= tau) x += kmat[((0 * 16 + (tau - sg)) * 16 + m) * 16 + mp];
          if (sg >= tau) x += kmat[((1 * 16 + (sg - tau)) * 16 + m) * 16 + mp];
          if (sg == tau && mp == m) x += p.ssm_d[s * 1024 + g * 16 + m];
          v[e] = x;
        }
      } else {
        int qq = k0 - 256, dir = qq >> 7, p0 = (qq & 127) >> 1;
        int ex = dir == 0 ? tau + 1 : 16 - tau;
#pragma unroll
        for (int e2 = 0; e2 < 4; ++e2) {
          int pp = p0 + e2;
          float cr = cc_re[(dir * 16 + m) * 64 + pp], ci = cc_im[(dir * 16 + m) * 64 + pp];
          float ar = ap_re[(dir * 64 + pp) * 17 + ex], ai = ap_im[(dir * 64 + pp) * 17 + ex];
          v[2 * e2] = cr * ar - ci * ai; v[2 * e2 + 1] = -(cr * ai + ci * ar);
        }
      }
      uint4 o; o.x = pack2(v[0], v[1]); o.y = pack2(v[2], v[3]); o.z = pack2(v[4], v[5]); o.w = pack2(v[6], v[7]);
      *reinterpret_cast<uint4*>(Tt + ((long)g * 256 + prow(n)) * 512 + k0) = o;
    }
    for (int gi = tid; gi < 64 * 32; gi += 512) {
      int n = qr * 64 + (gi >> 5), k0 = (gi & 31) * 8, dir = n >> 7, pp = (n & 127) >> 1, ri = n & 1;
      int sg = k0 >> 4, mp0 = k0 & 15, ex = dir == 0 ? 15 - sg : sg;
      float ar = ap_re[(dir * 64 + pp) * 17 + ex], ai = ap_im[(dir * 64 + pp) * 17 + ex];
      float v[8];
#pragma unroll
      for (int e = 0; e < 8; ++e) {
        float br = bb_re[(dir * 64 + pp) * 16 + mp0 + e], bi = bb_im[(dir * 64 + pp) * 16 + mp0 + e];
        v[e] = ri ? (ar * bi + ai * br) : (ar * br - ai * bi);
      }
      uint4 o; o.x = pack2(v[0], v[1]); o.y = pack2(v[2], v[3]); o.z = pack2(v[4], v[5]); o.w = pack2(v[6], v[7]);
      *reinterpret_cast<uint4*>(Pt + ((long)g * 256 + prow(n)) * 256 + k0) = o;
    }
  }
  __syncthreads();
}

struct ConvDesc { const float* src; u16* dst; int ld, K, N, mode, tstart, tend; };
DI void conv_table(const Params& p, int l, ConvDesc* tab, int* cnt, int zz) {
  char* ws = p.ws;
  const int a = l >> 1;
  int n = 0, ts = zz;
  auto add = [&](const float* src, u16* dst, int ld, int K, int N, int mode) {
    ConvDesc d; d.src = src; d.dst = dst; d.ld = ld + zz; d.K = K + zz; d.N = N + zz; d.mode = mode + zz; d.tstart = ts; ts += (K >> 6) * (N >> 6); d.tend = ts;
    tab[n++] = d;
  };
  if ((l & 1) == 0) {
    add(p.w_qkv + (long)a * 1024 * 1536, (u16*)(ws + OFF_WA), 1536, 1024, 1536, 3);
    add(p.w_o + (long)a * 1024 * 1024, (u16*)(ws + OFF_WB), 1024, 1024, 1024, 0);
  } else {
    add(p.ssm_w_in + (long)a * 1024 * 1024, (u16*)(ws + OFF_WA), 1024, 1024, 1024, 0);
    add(p.w_out + (long)a * 1024 * 1024, (u16*)(ws + OFF_WB), 1024, 1024, 1024, 0);
    add(p.w_glu + (long)a * 1024 * 2048, (u16*)(ws + OFF_WGLU), 2048, 1024, 1024, 1);
    add(p.w_glu + (long)a * 1024 * 2048 + 1024, (u16*)(ws + OFF_WGLU), 2048, 1024, 1024, 2);
  }
  add(p.w1 + (long)l * 1024 * DFF, (u16*)(ws + OFF_W13), DFF, 1024, DFF, 1);
  add(p.w3 + (long)l * 1024 * DFF, (u16*)(ws + OFF_W13), DFF, 1024, DFF, 2);
  add(p.w2 + (long)l * DFF * 1024, (u16*)(ws + OFF_W2), 1024, DFF, 1024, 0);
  *cnt = n;
}

DI void conv_layer(const Params& p, int l) {
  extern __shared__ __attribute__((aligned(16))) __hip_bfloat16 shm[];
  float* lds = (float*)shm;
  ConvDesc* tab = (ConvDesc*)((char*)shm + 4 * 64 * 65 * 4);
  int* cntp = (int*)((char*)shm + 4 * 64 * 65 * 4 + 8 * sizeof(ConvDesc));
  const int tidc = opaque_tid();
  int nb = gridDim.x, bid = blockIdx.x;
  __syncthreads();
  int zz = 0; asm volatile("" : "+s"(zz));
  if (tidc == 0) conv_table(p, l, tab, cntp, zz);
  __syncthreads();
  const int cnt = *cntp, total = tab[cnt - 1].tend;
  auto find = [&](int gt) -> int { int i = 0; while (i < cnt - 1 && gt >= tab[i].tend) ++i; return i; };
  auto issue = [&](int gt, float (&r)[8]) {
    const int i = find(gt);
    const float* src = tab[i].src; const int ld = tab[i].ld, tnn = tab[i].N >> 6, t = gt - tab[i].tstart, kt = t / tnn, nt = t % tnn;
    UNR for (int e = 0; e < 8; ++e) { int idx = tidc + 512 * e, kk = idx >> 6, nn = idx & 63; r[e] = __builtin_nontemporal_load(src + (long)(kt * 64 + kk) * ld + nt * 64 + nn); }
  };
  auto emit = [&](int gt, const float* L) {
    const int i = find(gt);
    u16* dst = tab[i].dst; const int K = tab[i].K, mode = tab[i].mode, tnn = tab[i].N >> 6, t = gt - tab[i].tstart, kt = t / tnn, nt = t % tnn;
    int n = tidc >> 3, k8 = (tidc & 7) * 8, ng = nt * 64 + n;
    const int a32 = ng & 31, pa = ((a32 >> 2) & 1) * 16 + (a32 >> 3) * 4 + (a32 & 3);
    int nr = (mode == 1 || mode == 2) ? ((ng >> 7) * 256 + (mode == 2 ? 128 : 0) + (ng & 96) + pa)
                                      : ((mode == 0 || ng < 1024) ? (ng & ~31) + pa : ng);
    uint4 o;
    o.x = pack2(L[(k8 + 0) * 65 + n], L[(k8 + 1) * 65 + n]); o.y = pack2(L[(k8 + 2) * 65 + n], L[(k8 + 3) * 65 + n]);
    o.z = pack2(L[(k8 + 4) * 65 + n], L[(k8 + 5) * 65 + n]); o.w = pack2(L[(k8 + 6) * 65 + n], L[(k8 + 7) * 65 + n]);
    *reinterpret_cast<uint4*>(dst + (long)nr * K + kt * 64 + k8) = o;
  };
  float r0[8], r1[8];
  int gt = 2 * bid, buf = 0;
  if (gt < total) issue(gt, r0);
  if (gt + 1 < total) issue(gt + 1, r1);
  for (; gt < total; gt += 2 * nb) {
    float* L0 = lds + buf * (2 * 64 * 65); float* L1 = L0 + 64 * 65;
    const bool two = gt + 1 < total;
    UNR for (int e = 0; e < 8; ++e) { int idx = tidc + 512 * e, kk = idx >> 6, nn = idx & 63; L0[kk * 65 + nn] = r0[e]; if (two) L1[kk * 65 + nn] = r1[e]; }
    if (gt + 2 * nb < total) issue(gt + 2 * nb, r0);
    if (gt + 2 * nb + 1 < total) issue(gt + 2 * nb + 1, r1);
    __syncthreads();
    emit(gt, L0);
    if (two) emit(gt + 1, L1);
    buf ^= 1;
  }
  if (l & 1) { __syncthreads(); ssm_prep(p, l >> 1); }
}

DI void prep_phase(const Params& p) {
  extern __shared__ __attribute__((aligned(16))) __hip_bfloat16 shm[];
  float* L = (float*)shm;
  const int tid = opaque_tid();
  for (int it = blockIdx.x; it < 192; it += gridDim.x) {
    float* sc = L;
    float* red = L + 9216;
    __syncthreads();
    for (int i = tid; i < 9216; i += 512) {
      int cd = i >> 10, k = i & 1023;
      float v = cd == 0 ? p.c_ctx[k] : p.c[(cd - 1) * 1024 + k];
      sc[i] = v * fast_sigmoid(v);
    }
    __syncthreads();
    const int cg4 = tid & 31, ks = tid >> 5;
    const int cidx = it * 128 + cg4 * 4, l = cidx / 6144, col = cidx % 6144;
    const float* w = p.w_ada + ((long)l * 1024 + ks * 64) * 6144 + col;
    float acc[9][4];
#pragma unroll
    for (int i = 0; i < 9; ++i) { acc[i][0] = 0.f; acc[i][1] = 0.f; acc[i][2] = 0.f; acc[i][3] = 0.f; }
#pragma unroll 8
    for (int k = 0; k < 64; ++k) {
      float4 wv = nt_load_f4(w + (long)k * 6144);
#pragma unroll
      for (int i = 0; i < 9; ++i) { float sv = sc[i * 1024 + ks * 64 + k]; acc[i][0] += sv * wv.x; acc[i][1] += sv * wv.y; acc[i][2] += sv * wv.z; acc[i][3] += sv * wv.w; }
    }
#pragma unroll
    for (int i = 0; i < 9; ++i) *reinterpret_cast<float4*>(red + (ks * 9 + i) * 128 + cg4 * 4) = make_float4(acc[i][0], acc[i][1], acc[i][2], acc[i][3]);
    __syncthreads();
    if (tid < 128) {
      const int c1 = it * 128 + tid, l1 = c1 / 6144, col1 = c1 % 6144;
      float bia = p.b_ada[l1 * 6144 + col1];
      float* mo = (float*)(p.ws + OFF_MODS);
#pragma unroll
      for (int i = 0; i < 9; ++i) {
        float v = bia;
#pragma unroll
        for (int k2 = 0; k2 < 16; ++k2) v += red[(k2 * 9 + i) * 128 + tid];
        mo[((long)(l1 * 9 + i)) * 6144 + col1] = v;
      }
    }
    __syncthreads();
  }
  if (blockIdx.x == gridDim.x - 1) {
    float* rope = (float*)(p.ws + OFF_ROPE);
    for (int i = tid; i < 1024; i += 512) {
      int pos = i >> 4, f = i & 15;
      float inv = exp2f(-(float)f * (13.287712379549449f / 16.f));
      float sn, cs; sincos_red((float)pos * inv, sn, cs);
      rope[i * 2] = cs; rope[i * 2 + 1] = sn;
    }
  }
  {
    u16* KC = (u16*)(p.ws + OFF_KC); u16* VTC = (u16*)(p.ws + OFF_VTC);
    const long nthr = (long)gridDim.x * 512, gt = (long)blockIdx.x * 512 + tid;
    for (long i = gt; i < 2097152 / 4; i += nthr) {
      float4 v = *reinterpret_cast<const float4*>(p.cache_k + i * 4);
      uint2 o; o.x = pack2(v.x, v.y); o.y = pack2(v.z, v.w);
      *reinterpret_cast<uint2*>(KC + i * 4) = o;
    }
    for (long i = gt; i < 16L * 64 * 256; i += nthr) {
      int col = (int)(i & 255), kg = (int)((i >> 8) & 63), ba = (int)(i >> 14);
      const float* src = p.cache_v + ((long)ba * 512 + kg * 8) * 256 + col;
      float v[8];
#pragma unroll
      for (int e = 0; e < 8; ++e) v[e] = src[e * 256];
      uint4 o; o.x = pack2(v[0], v[1]); o.y = pack2(v[2], v[3]); o.z = pack2(v[4], v[5]); o.w = pack2(v[6], v[7]);
      *reinterpret_cast<uint4*>(VTC + ((long)ba * 256 + col) * 512 + kg * 8) = o;
    }
  }
  __syncthreads();
  conv_layer(p, 0);
}

DI void scan_phase(const Params& p, int s) {
  const u16* S = (const u16*)(p.ws + OFF_R1 + R1_S);
  u16* Hin = (u16*)(p.ws + OFF_H);
  const int tidx = opaque_tid();
  const int lane = tidx & 63, gw = blockIdx.x * 8 + (tidx >> 6), nw = gridDim.x * 8;
  for (int it = gw; it < 3072; it += nw) {
    const bool lat = it < 1024;
    int seq, g, dir, nch, R0;
    if (lat) { dir = it & 1; g = (it >> 1) & 63; seq = it >> 7; nch = 256; R0 = 256 + seq * 256; }
    else { int j = it - 1024; dir = j & 1; g = (j >> 1) & 63; seq = j >> 7; nch = 16; R0 = seq * 16; }
    long li = ((long)(s * 2 + dir) * 64 + g) * 64 + lane;
    float dt = __expf(p.log_dt[(s * 2 + dir) * 64 + g]);
    float mag = __expf(16.f * p.lam_re[li] * dt), sn, cs;
    sincos_red(16.f * p.lam_im[li] * dt, sn, cs);
    const float ar = mag * cs, ai = mag * sn;
    float hr = 0.f, hi = 0.f;
    if (lat) { long si = ((long)((seq * 2 + s) * 2 + dir) * 64 + g) * 64 + lane; hr = p.st_re[si]; hi = p.st_im[si]; }
    const long off = (long)g * NCHR * 256 + dir * 128 + 2 * lane;
    for (int c0 = 0; c0 < nch; c0 += 16) {
      float2 sv[16];
#pragma unroll
      for (int i = 0; i < 16; ++i) {
        int c = dir == 0 ? c0 + i : nch - 1 - (c0 + i);
        unsigned w = __builtin_nontemporal_load(reinterpret_cast<const unsigned*>(S + (long)(R0 + c) * 256 + off));
        sv[i] = make_float2(__uint_as_float(w << 16), __uint_as_float(w & 0xffff0000u));
      }
#pragma unroll
      for (int i = 0; i < 16; ++i) {
        int c = dir == 0 ? c0 + i : nch - 1 - (c0 + i);
        *reinterpret_cast<unsigned*>(Hin + (long)(R0 + c) * 256 + off) = pack2(hr, hi);
        float nr = ar * hr - ai * hi + sv[i].x, ni = ar * hi + ai * hr + sv[i].y;
        hr = nr; hi = ni;
      }
    }
    if (!lat) {
      long oi = ((long)((seq * 2 + s) * 2 + dir) * 64 + g) * 64 + lane;
      p.out[OUT_SR + oi] = hr; p.out[OUT_SI + oi] = hi;
    }
  }
}

#define XB_TMO      128
#define XB_XCNT(j)  (256  + 64 * (j))
#define XB_XSUB(j)  (1280 + 64 * (j))
#define XB_XGEN(j)  (2304 + 64 * (j))
#define XB_TOP      3328
#define XB_TOPGEN   3392
#define XCD_BAR_WORDS 3456
#define XB_SPIN_CAP (1u << 18)
#define LAS __attribute__((address_space(3)))

__device__ __forceinline__ unsigned xb_ld(unsigned* p)              { return __hip_atomic_load(p, __ATOMIC_RELAXED, __HIP_MEMORY_SCOPE_AGENT); }
__device__ __forceinline__ unsigned xb_add(unsigned* p, unsigned v) { return __hip_atomic_fetch_add(p, v, __ATOMIC_RELAXED, __HIP_MEMORY_SCOPE_AGENT); }
__device__ __forceinline__ unsigned xb_xcc_id() { return (unsigned)__builtin_amdgcn_s_getreg((3 << 11) | 20) & 0xFu; }
#define XB_SPIN(cond, bar) do { unsigned _sp = 0; while (cond) { __builtin_amdgcn_s_sleep(1); \
    if ((++_sp & 255u) == 0u) { if (xb_ld(&(bar)[XB_TMO])) break; if (_sp > XB_SPIN_CAP) { atomicAdd(&(bar)[XB_TMO], 1u); break; } } } } while (0)

struct XcdBarrier {
    unsigned* bar; unsigned x;
    volatile LAS unsigned* st;
};

__device__ __forceinline__ XcdBarrier xcd_barrier_post(unsigned* bar, volatile LAS unsigned* st) {
    XcdBarrier b; b.bar = bar; b.x = xb_xcc_id(); b.st = st;
    if (threadIdx.x == 0) (void)xb_add(&bar[XB_XCNT(b.x)], 1u);
    return b;
}
__device__ __forceinline__ void xcd_barrier_complete(unsigned* bar, unsigned x, unsigned& nloc, unsigned& nx) {
    const unsigned G = gridDim.x * gridDim.y * gridDim.z;
    unsigned sum, cnt, mine, sp = 0u;
    for (;;) {
        sum = 0u; cnt = 0u; mine = 0u;
#pragma unroll
        for (unsigned j = 0; j < 16; ++j) { const unsigned c = xb_ld(&bar[XB_XCNT(j)]); sum += c; cnt += (c > 0u) ? 1u : 0u; mine = (j == x) ? c : mine; }
        if (sum == G) break;
        __builtin_amdgcn_s_sleep(1);
        if ((++sp & 255u) == 0u) { if (xb_ld(&bar[XB_TMO])) break; if (sp > XB_SPIN_CAP) { atomicAdd(&bar[XB_TMO], 1u); break; } }
    }
    nloc = mine > 0u ? mine : 1u; nx = cnt > 0u ? cnt : 1u;
}

__device__ __forceinline__ void xcd_barrier(const XcdBarrier& b) {
    asm volatile("s_waitcnt vmcnt(0)" ::: "memory");
    __syncthreads();
    if (threadIdx.x == 0) {
        unsigned* bar = b.bar;
        __builtin_amdgcn_s_waitcnt(0);
        unsigned nloc = b.st[0], nx = b.st[1];
        if (nloc == 0u) { xcd_barrier_complete(bar, b.x, nloc, nx); b.st[0] = nloc; b.st[1] = nx; }
        const unsigned old = xb_add(&bar[XB_XSUB(b.x)], 1u);
        const unsigned gen = old / nloc;
        if (old + 1u == (gen + 1u) * nloc) {
            __builtin_amdgcn_fence(__ATOMIC_RELEASE, "agent");
            asm volatile("s_waitcnt vmcnt(0)" ::: "memory");
            const unsigned og = xb_add(&bar[XB_TOP], 1u);
            const unsigned tg = og / nx;
            if (og + 1u == (tg + 1u) * nx) xb_add(&bar[XB_TOPGEN], 1u);
            else XB_SPIN(xb_ld(&bar[XB_TOPGEN]) == tg, bar);
            __builtin_amdgcn_fence(__ATOMIC_ACQUIRE, "agent");
            xb_add(&bar[XB_XGEN(b.x)], 1u);
            asm volatile("s_waitcnt vmcnt(0)" ::: "memory");
        } else {
            XB_SPIN(xb_ld(&bar[XB_XGEN(b.x)]) == gen, bar);
            __builtin_amdgcn_fence(__ATOMIC_ACQUIRE, "agent");
            asm volatile("s_waitcnt vmcnt(0)" ::: "memory");
        }
    }
    __syncthreads();
}


constexpr int NPHASE = 36;
constexpr int SHM_DYN = SHM_B + 256;

template <int EPI>
DI void gemm_tail_split(const Params& p, GemmArgs g) {
  const int G = gridDim.x, ntiles = g.nM * g.nN, rem = ntiles % G, nfull = ntiles - rem;
  if (rem == 0 || rem * 2 > G || nfull == 0) { gemm_sp2<EPI, 4>(p, g); return; }
  g.tbase = 0; g.sub = 1; g.ucount = nfull;
  gemm_sp2<EPI, 4>(p, g);
  g.tbase = nfull; g.sub = 2; g.ucount = rem * 2;
  gemm_sp2<EPI, 2>(p, g);
}

DI void ffn1(const Params& p, int l) {
  GemmArgs g{}; g.A = (const u16*)(p.ws + OFF_H); g.lda = 1024; g.Bt = (const u16*)(p.ws + OFF_W13); g.K = 1024; g.nM = 144; g.nN = 22;
  g.act = 0; g.ldo = DFF; g.o16 = (u16*)(p.ws + OFF_R1);
  gemm_tail_split<EPI_GATED>(p, g);
}
DI void res_gemm(const Params& p, int l, const u16* A, int lda, const u16* Bt, int K, int gidx) {
  const int lnp = gidx == 5 ? l * 2 : (l == 0 ? -1 : (l - 1) * 2 + 1);
  GemmArgs g{}; g.A = A; g.lda = lda; g.Bt = Bt; g.K = K; g.nM = 192; g.nN = 4; g.layer = l; g.gidx = gidx; g.lnp = lnp; g.o32 = (float*)(p.ws + OFF_X); g.rev = (K == DFF) ? 1 : 0;
  gemm_sp2<EPI_RES, 3>(p, g);
}

DI void run_phase(const Params& pin, int ph) {
  Params p = pin;
  { long z = 0; asm volatile("" : "+s"(z)); p.ws = pin.ws + z; p.out = pin.out + z;
#define OPQ(f) p.f = pin.f + z;
    OPQ(x_prompt) OPQ(x_sample) OPQ(cache_k) OPQ(cache_v) OPQ(st_re) OPQ(st_im) OPQ(c) OPQ(c_ctx) OPQ(w_ada) OPQ(b_ada) OPQ(ln_g) OPQ(ln_b)
    OPQ(w_qkv) OPQ(w_o) OPQ(sink) OPQ(ssm_w_in) OPQ(lam_re) OPQ(lam_im) OPQ(log_dt) OPQ(b_re) OPQ(b_im) OPQ(c_re) OPQ(c_im) OPQ(ssm_d) OPQ(w_glu) OPQ(w_out)
    OPQ(w1) OPQ(w3) OPQ(w2)
#undef OPQ
  }
  if (ph == 0) { prep_phase(p); return; }
  if (ph == 1) { row_phase(p, 0, 0, 0, 0, 0); return; }
  int q = ph - 2, l, sub;
  if (q < 7) { l = 0; sub = q; } else if (q < 17) { l = 1; sub = q - 7; } else if (q < 24) { l = 2; sub = q - 17; } else { l = 3; sub = q - 24; }
  const bool is_attn = (l & 1) == 0;
  int tail = is_attn ? sub - 3 : sub - 6;
  if (tail < 0) {
    if (is_attn) {
      if (sub == 0) {
        GemmArgs g{}; g.A = (const u16*)(p.ws + OFF_H); g.lda = 1024; g.Bt = (const u16*)(p.ws + OFF_WA); g.K = 1024; g.nM = 144; g.nN = 6; g.attn_a = l >> 1;
        gemm_tail_split<EPI_QKV>(p, g);
      } else if (sub == 1) {
        attn_phase(p, l >> 1);
      } else {
        res_gemm(p, l, (const u16*)(p.ws + OFF_R1 + R1_O), 1024, (const u16*)(p.ws + OFF_WB), 1024, 2);
      }
    } else {
      if (sub == 0) {
        GemmArgs g{}; g.A = (const u16*)(p.ws + OFF_H); g.lda = 1024; g.Bt = (const u16*)(p.ws + OFF_WA); g.K = 1024; g.nM = 192; g.nN = 4;
        g.ldo = 1024; g.act = 2; g.o16 = (u16*)(p.ws + OFF_R1 + R1_U);
        gemm_sp2<EPI_PLAIN, 3>(p, g);
      } else if (sub == 1) {
        GemmArgs g{}; g.A = (const u16*)(p.ws + OFF_R1 + R1_U); g.Bt = (const u16*)(p.ws + OFF_PT); g.K = 256; g.nM = 12; g.nN = 1;
        g.o16 = (u16*)(p.ws + OFF_R1 + R1_S);
        gemm_sp2<EPI_S, 3, 1>(p, g);
      } else if (sub == 2) {
        scan_phase(p, l >> 1);
      } else if (sub == 3) {
        GemmArgs g{}; g.A = (const u16*)(p.ws + OFF_R1 + R1_U); g.A2 = (const u16*)(p.ws + OFF_H); g.Bt = (const u16*)(p.ws + OFF_TT); g.K = 512; g.nM = 12; g.nN = 1;
        g.o16 = (u16*)(p.ws + OFF_R1 + R1_G);
        gemm_sp2<EPI_Y, 3, 2>(p, g);
      } else if (sub == 4) {
        GemmArgs g{}; g.A = (const u16*)(p.ws + OFF_R1 + R1_G); g.lda = 1024; g.Bt = (const u16*)(p.ws + OFF_WGLU); g.K = 1024; g.nM = 144; g.nN = 8;
        g.act = 1; g.ldo = 1024; g.o16 = (u16*)(p.ws + OFF_R1 + R1_GL);
        gemm_tail_split<EPI_GATED>(p, g);
      } else {
        res_gemm(p, l, (const u16*)(p.ws + OFF_R1 + R1_GL), 1024, (const u16*)(p.ws + OFF_WB), 1024, 2);
      }
    }
    return;
  }
  if (tail == 0) { row_phase(p, 1, l, 0, l, 3); return; }
  if (tail == 1) { ffn1(p, l); return; }
  if (tail == 2) { res_gemm(p, l, (const u16*)(p.ws + OFF_R1), DFF, (const u16*)(p.ws + OFF_W2), DFF, 5); return; }
  if (l == 3) { row_phase(p, 2, l, 1, 0, 0); return; }
  row_phase(p, 1, l, 1, l + 1, 0);
  __syncthreads();
  conv_layer(p, l + 1);
}

#ifndef PROBE_DUP
#define PROBE_DUP 0
#endif
enum { K_PREP = 0, K_INIT, K_QKV, K_ATTN, K_WO, K_LN, K_FFN1, K_FFN2, K_WIN, K_SSMS, K_SCAN, K_SSMY, K_GLU, K_WOUT };
DI int phase_kind(int ph) {
  if (ph == 0) return K_PREP;
  if (ph == 1) return K_INIT;
  int q = ph - 2, l, sub;
  if (q < 7) { l = 0; sub = q; } else if (q < 17) { l = 1; sub = q - 7; } else if (q < 24) { l = 2; sub = q - 17; } else { l = 3; sub = q - 24; }
  if ((l & 1) == 0) return (int)((0x5765432ULL >> (4 * sub)) & 15);
  return (int)((0x5765DCBA98ULL >> (4 * sub)) & 15);
}

__global__ void __launch_bounds__(512) mk_forward(Params p, int ph_lo, int ph_hi) {
  extern __shared__ __attribute__((aligned(16))) __hip_bfloat16 shm[];
  XcdBarrier xb;
  if (ph_hi - ph_lo > 1) {
    volatile LAS unsigned* st = (volatile LAS unsigned*)((LAS char*)shm + SHM_B);
    if (threadIdx.x == 0) { st[0] = 0u; st[1] = 0u; }
    __syncthreads();
    xb = xcd_barrier_post((unsigned*)(p.ws + OFF_BAR), st);
  }
  for (int ph = ph_lo; ph < ph_hi; ++ph) {
    run_phase(p, ph);
#if PROBE_DUP
    if ((PROBE_DUP >> phase_kind(ph)) & 1) { int reps = phase_kind(ph) == K_INIT ? 4 : 1; for (int r = 0; r < reps; ++r) run_phase(p, ph); }
#endif
    if (ph + 1 < ph_hi) {
      if (ph == ph_lo) cg::this_grid().sync();
      else xcd_barrier(xb);
    }
  }
}

extern "C" void kernel_launch(void* const* d_in, const int* in_sizes, int n_in, void* d_out, int out_size, void* d_ws,
                              size_t ws_size, hipStream_t stream) {
  Params p{};
  const float** f = (const float**)&p;
  for (int i = 0; i < 29; ++i) f[i] = (const float*)d_in[i];
  p.out = (float*)d_out; p.ws = (char*)d_ws;
  static int grid_blocks = 0;
  if (!grid_blocks) {
    hipFuncSetAttribute((const void*)mk_forward, hipFuncAttributeMaxDynamicSharedMemorySize, SHM_DYN);
    int dev = 0, cus = 0, per_cu = 0;
    hipGetDevice(&dev);
    hipDeviceGetAttribute(&cus, hipDeviceAttributeMultiprocessorCount, dev);
    hipOccupancyMaxActiveBlocksPerMultiprocessor(&per_cu, mk_forward, 512, SHM_DYN);
    if (per_cu < 1) per_cu = 1;
    grid_blocks = cus * per_cu;
    if (ws_size < WS_TOTAL) fprintf(stderr, "workspace too small: %zu < %zu\n", ws_size, (size_t)WS_TOTAL);
  }
#if ONE_LAUNCH
  int lo = 0, hi = NPHASE;
  void* args[] = {&p, &lo, &hi};
  hipMemsetAsync((char*)d_ws + OFF_BAR, 0, XCD_BAR_WORDS * sizeof(unsigned), stream);
  hipError_t e = hipLaunchCooperativeKernel((void*)mk_forward, dim3(grid_blocks), dim3(512), args, SHM_DYN, stream);
  if (e != hipSuccess) fprintf(stderr, "cooperative launch failed: %s (grid %d)\n", hipGetErrorString(e), grid_blocks);
#else
  for (int ph = 0; ph < NPHASE; ++ph) mk_forward<<<dim3(grid_blocks), dim3(512), SHM_DYN, stream>>>(p, ph, ph + 1);
#endif
}
```

```cpp
#include <hip/hip_runtime.h>
#include <hip/hip_bf16.h>
#include <hip/hip_cooperative_groups.h>
#include <cstdio>
namespace cg = cooperative_groups;

#ifndef ONE_LAUNCH
#define ONE_LAUNCH 1
#endif

typedef unsigned short u16;
using bf16x8 = __attribute__((ext_vector_type(8))) short;
using f32x4  = __attribute__((ext_vector_type(4))) float;
using f32x16 = __attribute__((ext_vector_type(16))) float;
#define DI __device__ __forceinline__
#define UNR _Pragma("unroll")

constexpr int D = 1024, DFF = 2816, MCTX = 4096, MLAT = 32768, MTOK = 36864;
constexpr int NCHR = 2304;
constexpr float DN_ALPHA = 1.681792830507429f;
constexpr float LN_EPS = 1e-5f;

constexpr long OUT_CK = 37748736L, OUT_CV = 39845888L, OUT_SR = 41943040L, OUT_SI = 42205184L;

constexpr size_t OFF_MODS = 0;
constexpr size_t OFF_ROPE = 1048576;
constexpr size_t OFF_KC   = OFF_ROPE + 65536;
constexpr size_t OFF_VTC  = OFF_KC + 4194304;
constexpr size_t OFF_STATS = OFF_VTC + 4194304;
constexpr size_t OFF_BAR  = OFF_STATS + 524288;
constexpr size_t OFF_X    = OFF_STATS + 1048576;
constexpr size_t OFF_H    = OFF_X + (size_t)MTOK * 4096;
constexpr size_t OFF_WA   = OFF_H + (size_t)MTOK * 2048;
constexpr size_t OFF_WB   = OFF_WA + 4194304;
constexpr size_t OFF_WGLU = OFF_WB + 2097152;
constexpr size_t OFF_W13  = OFF_WGLU + 4194304;
constexpr size_t OFF_W2   = OFF_W13 + 11534336;
constexpr size_t OFF_PT   = OFF_W2 + 5767168;
constexpr size_t OFF_TT   = OFF_PT + 8388608;
constexpr size_t OFF_R1   = OFF_TT + 16777216;
constexpr size_t R1_Q = 0, R1_KB = (size_t)MTOK * 2048, R1_VT = (size_t)MTOK * 2560, R1_O = (size_t)MTOK * 3072;
constexpr size_t R1_U = 0, R1_S = (size_t)MTOK * 2048, R1_G = (size_t)MTOK * 4096, R1_GL = 0;
constexpr size_t WS_TOTAL = OFF_R1 + (size_t)MTOK * 6144;

struct Params {
  const float *x_prompt, *x_sample, *cache_k, *cache_v, *st_re, *st_im, *c, *c_ctx, *w_ada, *b_ada, *ln_g, *ln_b,
      *w_qkv, *w_o, *sink, *ssm_w_in, *lam_re, *lam_im, *log_dt, *b_re, *b_im, *c_re, *c_im, *ssm_d, *w_glu, *w_out,
      *w1, *w3, *w2;
  float* out;
  char* ws;
};

DI int opaque_tid() {
  int w = __builtin_amdgcn_readfirstlane((int)threadIdx.x >> 6);
  int l;
  asm volatile("v_mbcnt_lo_u32_b32 %0, -1, 0\n\tv_mbcnt_hi_u32_b32 %0, -1, %0" : "=v"(l));
  return (w << 6) | l;
}
typedef __bf16 hwbf16x2 __attribute__((ext_vector_type(2)));
typedef float hwf32x2 __attribute__((ext_vector_type(2)));
DI unsigned pack2(float a, float b) { hwf32x2 v = {a, b}; hwbf16x2 r = __builtin_convertvector(v, hwbf16x2); return __builtin_bit_cast(unsigned, r); }
DI u16 f2bf(float f) { return (u16)(pack2(f, 0.f) & 0xffffu); }
DI float bf2f(u16 h) { return __uint_as_float(((unsigned)h) << 16); }
DI float shfl_xor_l(float v, int lane, int mask) { return __int_as_float(__builtin_amdgcn_ds_bpermute((lane ^ mask) << 2, __float_as_int(v))); }
DI float xhalf_max(float v) { auto r = __builtin_amdgcn_permlane32_swap(__float_as_uint(v), __float_as_uint(v), false, false); return fmaxf(__uint_as_float(r[0]), __uint_as_float(r[1])); }
DI float xhalf_sum(float v) { auto r = __builtin_amdgcn_permlane32_swap(__float_as_uint(v), __float_as_uint(v), false, false); return __uint_as_float(r[0]) + __uint_as_float(r[1]); }
DI float wave_sum(float v, int lane) {
#pragma unroll
  for (int o = 32; o > 0; o >>= 1) v += shfl_xor_l(v, lane, o);
  return v;
}
typedef unsigned u32x2v __attribute__((ext_vector_type(2)));
DI float4 nt_load_f4(const float* p) { f32x4 v = __builtin_nontemporal_load(reinterpret_cast<const f32x4*>(p)); return make_float4(v[0], v[1], v[2], v[3]); }
DI uint2 nt_load_u2(const u16* p) { u32x2v v = __builtin_nontemporal_load(reinterpret_cast<const u32x2v*>(p)); return make_uint2(v[0], v[1]); }
typedef unsigned u32x4v __attribute__((ext_vector_type(4)));
DI uint4 nt_load_u4(const void* p) { u32x4v v = __builtin_nontemporal_load(reinterpret_cast<const u32x4v*>(p)); return make_uint4(v[0], v[1], v[2], v[3]); }
DI void nt_store_f4(float* p, float4 x) { f32x4 v = {x.x, x.y, x.z, x.w}; __builtin_nontemporal_store(v, reinterpret_cast<f32x4*>(p)); }
DI int cond_of_row(int row) { return row < MCTX ? 0 : 1 + ((row - MCTX) >> 12); }
DI const float* mods_ptr(const Params& p, int l, int cond, int idx) {
  return (const float*)(p.ws + OFF_MODS) + ((size_t)((l * 9 + cond) * 6 + idx)) * 1024;
}
DI float fast_sigmoid(float x) { return __builtin_amdgcn_rcpf(1.f + __builtin_amdgcn_exp2f(-1.4426950408889634f * x)); }
DI float gelu_tanh(float x) { float u = 0.7978845608028654f * (x + 0.044715f * x * x * x); return x * fast_sigmoid(2.f * u); }

constexpr int BM = 256, BK = 64, HALF = 128, HT = HALF * BK, SHM_B = 8 * HT * 2;

DI int lds_byte(int r, int c) {
  int st = (r >> 4) * 2 + (c >> 5), rr = r & 15, cc = c & 31, ob = rr * 64 + cc * 2;
  return st * 1024 + (ob ^ (((ob >> 9) & 1) << 5));
}
DI void stage_rc(int b, int& R, int& C) {
  int st = b / 1024, sb = b % 1024, swz = sb ^ (((sb >> 9) & 1) << 5);
  R = (st >> 1) * 16 + swz / 64; C = (st & 1) * 32 + (swz % 64) / 2;
}

constexpr bool SPLITK_TAIL = false;
enum { EPI_QKV = 0, EPI_RES = 1, EPI_GATED = 2, EPI_PLAIN = 3, EPI_S = 4, EPI_Y = 5 };

struct GemmArgs {
  const u16* A;
  const u16* A2;
  const u16* Bt;
  int lda, K, nM, nN;
  int layer;
  int gidx;
  int lnp;
  int act;
  int ldo;
  int attn_a;
  int rev;
  int tbase, sub, ucount;
  u16* o16;
  float* o32;
};

template <int EPI, int MT>
DI void gemm_epilogue(const Params& p, const GemmArgs& ga, f32x4 (&acc)[2][2][MT][2], int brow, int bcol, int pn, int grp) {
  constexpr int MROWS = MT * 16, HROWS = 2 * MROWS;
  {
    const int te = opaque_tid();
    const int wid = te >> 6, lane = te & 63, wr = wid >> 2, wc = wid & 3, fr = lane & 15, fq = lane >> 4;
    const int cond = cond_of_row(brow);
    if (EPI == EPI_RES) {
      const float* stats = (const float*)(p.ws + OFF_STATS);
      const float* lg = p.ln_g + (ga.lnp < 0 ? 0 : ga.lnp) * 1024; const float* lb = p.ln_b + (ga.lnp < 0 ? 0 : ga.lnp) * 1024;
      UNR for (int ai = 0; ai < 2; ++ai) UNR for (int m = 0; m < MT; ++m) {
        const int row = brow + ai * HROWS + wr * MROWS + m * 16 + fr;
        const float* gate = mods_ptr(p, ga.layer, cond_of_row(row), ga.gidx);
        float mu = 0.f, rs = 1.f;
        const float* src = row < MCTX ? p.x_prompt + (long)row * D : p.x_sample + (long)(row - MCTX) * D;
        u16* xb = (u16*)ga.o32 + (long)row * D;
        if (ga.lnp >= 0) { float2 st = *reinterpret_cast<const float2*>(stats + (long)row * 2); mu = st.x; rs = st.y; }
        UNR for (int bj = 0; bj < 2; ++bj) {
          const int col0 = bcol + bj * HALF + wc * 32 + fq * 8;
          float xv[8];
          if (ga.lnp >= 0) {
            uint4 raw = nt_load_u4(xb + col0);
            xv[0] = __uint_as_float(raw.x << 16); xv[1] = __uint_as_float(raw.x & 0xffff0000u); xv[2] = __uint_as_float(raw.y << 16); xv[3] = __uint_as_float(raw.y & 0xffff0000u);
            xv[4] = __uint_as_float(raw.z << 16); xv[5] = __uint_as_float(raw.z & 0xffff0000u); xv[6] = __uint_as_float(raw.w << 16); xv[7] = __uint_as_float(raw.w & 0xffff0000u);
          }
          UNR for (int n = 0; n < 2; ++n) {
            const int col = col0 + n * 4;
            float4 g4 = *reinterpret_cast<const float4*>(gate + col);
            f32x4 a = acc[ai][bj][m][n];
            float4 x;
            if (ga.lnp >= 0) {
              float4 w4 = *reinterpret_cast<const float4*>(lg + col), b4 = *reinterpret_cast<const float4*>(lb + col);
              x.x = (xv[n * 4 + 0] - mu) * rs * w4.x + b4.x; x.y = (xv[n * 4 + 1] - mu) * rs * w4.y + b4.y;
              x.z = (xv[n * 4 + 2] - mu) * rs * w4.z + b4.z; x.w = (xv[n * 4 + 3] - mu) * rs * w4.w + b4.w;
            } else x = nt_load_f4(src + col);
            xv[n * 4 + 0] = DN_ALPHA * x.x + g4.x * a[0]; xv[n * 4 + 1] = DN_ALPHA * x.y + g4.y * a[1];
            xv[n * 4 + 2] = DN_ALPHA * x.z + g4.z * a[2]; xv[n * 4 + 3] = DN_ALPHA * x.w + g4.w * a[3];
          }
          uint4 o; o.x = pack2(xv[0], xv[1]); o.y = pack2(xv[2], xv[3]); o.z = pack2(xv[4], xv[5]); o.w = pack2(xv[6], xv[7]);
          *reinterpret_cast<uint4*>(xb + col0) = o;
        }
      }
    } else if (EPI == EPI_GATED) {
      UNR for (int ai = 0; ai < 2; ++ai) UNR for (int m = 0; m < MT; ++m) {
        const int row = brow + ai * HROWS + wr * MROWS + m * 16 + fr, col = pn * HALF + wc * 32 + fq * 8;
        float r[8];
        UNR for (int n = 0; n < 2; ++n) {
          f32x4 a = acc[ai][0][m][n], b = acc[ai][1][m][n];
          UNR for (int j = 0; j < 4; ++j) r[n * 4 + j] = ga.act == 0 ? a[j] * fast_sigmoid(a[j]) * b[j] : a[j] * fast_sigmoid(b[j]);
        }
        uint4 o; o.x = pack2(r[0], r[1]); o.y = pack2(r[2], r[3]); o.z = pack2(r[4], r[5]); o.w = pack2(r[6], r[7]);
        *reinterpret_cast<uint4*>(ga.o16 + (long)row * ga.ldo + col) = o;
      }
    } else if (EPI == EPI_PLAIN) {
      UNR for (int ai = 0; ai < 2; ++ai) UNR for (int bj = 0; bj < 2; ++bj) UNR for (int m = 0; m < MT; ++m) {
        int row = brow + ai * HROWS + wr * MROWS + m * 16 + fr, col = bcol + bj * HALF + wc * 32 + fq * 8;
        f32x4 a0 = acc[ai][bj][m][0], a1 = acc[ai][bj][m][1];
        uint4 o; o.x = pack2(a0[0], a0[1]); o.y = pack2(a0[2], a0[3]); o.z = pack2(a1[0], a1[1]); o.w = pack2(a1[2], a1[3]);
        if (ga.act == 2) *reinterpret_cast<uint4*>(ga.o16 + ((long)(col >> 4) * MTOK + row) * 16 + (col & 15)) = o;
        else *reinterpret_cast<uint4*>(ga.o16 + (long)row * ga.ldo + col) = o;
      }
    } else if (EPI == EPI_S) {
      UNR for (int ai = 0; ai < 2; ++ai) UNR for (int bj = 0; bj < 2; ++bj) UNR for (int m = 0; m < MT; ++m) {
        int R = brow + ai * HROWS + wr * MROWS + m * 16 + fr, col = bj * HALF + wc * 32 + fq * 8;
        f32x4 a0 = acc[ai][bj][m][0], a1 = acc[ai][bj][m][1];
        uint4 o; o.x = pack2(a0[0], a0[1]); o.y = pack2(a0[2], a0[3]); o.z = pack2(a1[0], a1[1]); o.w = pack2(a1[2], a1[3]);
        *reinterpret_cast<uint4*>(ga.o16 + ((long)grp * NCHR + R) * 256 + col) = o;
      }
    } else if (EPI == EPI_Y) {
      UNR for (int ai = 0; ai < 2; ++ai) UNR for (int bj = 0; bj < 2; ++bj) UNR for (int m = 0; m < MT; ++m) {
        int R = brow + ai * HROWS + wr * MROWS + m * 16 + fr, tau = bj * 8 + wc * 2 + (fq >> 1), ch = (fq & 1) * 8;
        f32x4 a0 = acc[ai][bj][m][0], a1 = acc[ai][bj][m][1]; uint4 o;
        o.x = pack2(gelu_tanh(a0[0]), gelu_tanh(a0[1])); o.y = pack2(gelu_tanh(a0[2]), gelu_tanh(a0[3]));
        o.z = pack2(gelu_tanh(a1[0]), gelu_tanh(a1[1])); o.w = pack2(gelu_tanh(a1[2]), gelu_tanh(a1[3]));
        *reinterpret_cast<uint4*>(ga.o16 + ((long)R * 16 + tau) * 1024 + grp * 16 + ch) = o;
      }
    } else {
      u16* Q = (u16*)(p.ws + OFF_R1 + R1_Q); u16* KB = (u16*)(p.ws + OFF_R1 + R1_KB); u16* VT = (u16*)(p.ws + OFF_R1 + R1_VT);
      const float* rope = (const float*)(p.ws + OFF_ROPE);
      const bool is_ctx = brow < MCTX;
      if (pn < 4) {
        UNR for (int ai = 0; ai < 2; ++ai) UNR for (int bj = 0; bj < 2; ++bj) UNR for (int m = 0; m < MT; ++m) {
          int row = brow + ai * HROWS + wr * MROWS + m * 16 + fr, col = bcol + bj * HALF + wc * 32 + fq * 8;
          f32x4 a0 = acc[ai][bj][m][0], a1 = acc[ai][bj][m][1];
          uint4 o; o.x = pack2(a0[0], a0[1]); o.y = pack2(a0[2], a0[3]); o.z = pack2(a1[0], a1[1]); o.w = pack2(a1[2], a1[3]);
          *reinterpret_cast<uint4*>(Q + (long)row * 1024 + col) = o;
        }
      } else if (pn == 4) {
        UNR for (int ai = 0; ai < 2; ++ai) UNR for (int bj = 0; bj < 2; ++bj) UNR for (int m = 0; m < MT; ++m) {
          int row = brow + ai * HROWS + wr * MROWS + m * 16 + fr, c0 = bj * HALF + wc * 32 + fq * 4;
          f32x4 x1 = acc[ai][bj][m][0], x2 = acc[ai][bj][m][1];
          if (is_ctx) {
            int b = row >> 8, t = row & 255;
            float* ck = p.out + OUT_CK + ((long)(b * 2 + ga.attn_a) * 256 + t) * 256;
            *reinterpret_cast<float4*>(ck + c0) = make_float4(x1[0], x1[1], x1[2], x1[3]);
            *reinterpret_cast<float4*>(ck + c0 + 16) = make_float4(x2[0], x2[1], x2[2], x2[3]);
          } else {
            int t = (row - MCTX) & 4095; int pos = (wc & 1) ? (t & 63) : (t >> 6);
            const float* cs = rope + (pos * 16 + fq * 4) * 2;
            float4 cs01 = *reinterpret_cast<const float4*>(cs), cs23 = *reinterpret_cast<const float4*>(cs + 4);
            float cc[4] = {cs01.x, cs01.z, cs23.x, cs23.z}, ss[4] = {cs01.y, cs01.w, cs23.y, cs23.w};
            UNR for (int j = 0; j < 4; ++j) { float a = x1[j], b2 = x2[j]; x1[j] = a * cc[j] - b2 * ss[j]; x2[j] = a * ss[j] + b2 * cc[j]; }
          }
          uint2 o1, o2; o1.x = pack2(x1[0], x1[1]); o1.y = pack2(x1[2], x1[3]); o2.x = pack2(x2[0], x2[1]); o2.y = pack2(x2[2], x2[3]);
          *reinterpret_cast<uint2*>(KB + (long)row * 256 + c0) = o1;
          *reinterpret_cast<uint2*>(KB + (long)row * 256 + c0 + 16) = o2;
        }
      } else {
        UNR for (int ai = 0; ai < 2; ++ai) UNR for (int bj = 0; bj < 2; ++bj) UNR for (int m = 0; m < MT; ++m) UNR for (int n = 0; n < 2; ++n) {
          int row = brow + ai * HROWS + wr * MROWS + m * 16 + fr, c0 = bj * HALF + wc * 32 + n * 16 + fq * 4;
          f32x4 a = acc[ai][bj][m][n];
          if (is_ctx) {
            int b = row >> 8, t = row & 255;
            float* cv = p.out + OUT_CV + ((long)(b * 2 + ga.attn_a) * 256 + t) * 256;
            *reinterpret_cast<float4*>(cv + c0) = make_float4(a[0], a[1], a[2], a[3]);
            u16* vt = VT + ((long)b * 256 + c0) * 256 + t;
            UNR for (int j = 0; j < 4; ++j) vt[j * 256] = f2bf(a[j]);
          } else {
            int b = (row - MCTX) >> 12, t = (row - MCTX) & 4095;
            u16* vt = VT + (long)16 * 256 * 256 + ((long)b * 256 + c0) * 4096 + t;
            UNR for (int j = 0; j < 4; ++j) vt[j * 4096] = f2bf(a[j]);
          }
        }
      }
    }
  }
}

template <int AMODE, int EPI, int MT = 4>
DI void gemm_phase(const Params& p, const GemmArgs& ga) {
  constexpr int MROWS = MT * 16, HROWS = 2 * MROWS, TROWS = 2 * HROWS;
  extern __shared__ __attribute__((aligned(16))) __hip_bfloat16 shm[];
#define SA(b, h) (shm + ((b) * 2 + (h)) * HT)
#define SB(b, h) (shm + (4 + (b) * 2 + (h)) * HT)
#define GLDS(src, dst) __builtin_amdgcn_global_load_lds((const unsigned*)(src), (unsigned*)(dst), 16, 0, 0)
#define STA(P, h, kt) do { const char* _s = (const char*)a_base(h, kt); \
    GLDS(_s + (size_t)offA, (char*)(P) + wsid * 1024); GLDS(_s + skipA + (size_t)offA, (char*)(P) + wsid * 1024 + 8192); } while (0)
#define STB(P, h, kt) do { const char* _s = (const char*)(T.Bb + (long)((h) * HALF) * K + (long)(kt) * BK); \
    GLDS(_s + (size_t)offB, (char*)(P) + wsid * 1024); GLDS(_s + skipB + (size_t)offB, (char*)(P) + wsid * 1024 + 8192); } while (0)
#define LDA(dst, b, h) UNR for (int m = 0; m < MT; ++m) UNR for (int k = 0; k < 2; ++k) \
    dst[m][k] = *reinterpret_cast<const bf16x8*>((char*)SA(b, h) + lds_byte(wr * MROWS + m * 16 + fr, k * 32 + fq * 8))
#define LDB(dst, b, h) UNR for (int n = 0; n < 2; ++n) UNR for (int k = 0; k < 2; ++k) \
    dst[n][k] = *reinterpret_cast<const bf16x8*>((char*)SB(b, h) + lds_byte(wc * 32 + n * 16 + fr, k * 32 + fq * 8))
#define MMA(ai, bj, Af, Bf) do { __builtin_amdgcn_s_setprio(1); \
    UNR for (int m = 0; m < MT; ++m) UNR for (int n = 0; n < 2; ++n) UNR for (int k = 0; k < 2; ++k) \
      acc[ai][bj][m][n] = __builtin_amdgcn_mfma_f32_16x16x32_bf16(Bf[n][k], Af[m][k], acc[ai][bj][m][n], 0, 0, 0); \
    __builtin_amdgcn_s_setprio(0); } while (0)
#define WAIT_V(n) asm volatile("s_waitcnt vmcnt(" #n ")" ::: "memory")
#define WAIT_L(n) asm volatile("s_waitcnt lgkmcnt(" #n ")" ::: "memory")
#define BAR __builtin_amdgcn_s_barrier()
#define SCHED __builtin_amdgcn_sched_barrier(0)

  const int K = ga.K, nM = ga.nM, nN = ga.nN;
  const int ntiles = (AMODE == 0) ? nM * nN : 9 * 64;
  const int tidx = opaque_tid();
  const int wsid = __builtin_amdgcn_readfirstlane((int)threadIdx.x >> 6);
  const int wid = tidx >> 6, lane = tidx & 63, wr = wid >> 2, wc = wid & 3, fr = lane & 15, fq = lane >> 4;
  unsigned offA, offB;
  {
    int R0, C0;
    stage_rc(tidx * 16, R0, C0);
    if (AMODE == 0) offA = (R0 * ga.lda + C0) * 2;
    else offA = (R0 * 256 + C0) * 2;
    offB = (R0 * K + C0) * 2;
  }
  const long skipA = AMODE == 0 ? (long)ga.lda * 128 : 64L * 256 * 2; const long skipB = (long)K * 128;
  const int nt_total = K / BK;
  const int G = gridDim.x;
  int nfull = ntiles, sp = 1;
  if (EPI == EPI_RES) {
    int rem = ntiles % G, pairs = nt_total >> 1;
    if (SPLITK_TAIL && rem) { if (rem * 4 <= G && pairs >= 8) sp = 4; else if (rem * 2 <= G && pairs >= 4) sp = 2; }
    if (sp > 1) nfull = ntiles - rem;
  }
  const int nunits = nfull + (ntiles - nfull) * sp;
  int vb = blockIdx.x;
  if ((G & 7) == 0) vb = (blockIdx.x & 7) * (G >> 3) + (blockIdx.x >> 3);

  struct GTile { int brow, bcol, pn, grp, nt, split; const u16 *Ab, *Ab2, *Bb; };
  auto decode = [&](int u, GTile& T) {
    int tile = u, kt0 = 0; T.nt = nt_total; T.split = 0;
    if (EPI == EPI_RES && u >= nfull) {
      int v = u - nfull, part = v % sp; tile = nfull + v / sp;
      int pairs = nt_total >> 1, qq = pairs / sp, rr = pairs % sp;
      kt0 = 2 * (part * qq + min(part, rr)); T.nt = 2 * (qq + (part < rr ? 1 : 0)); T.split = 1;
    }
    int pm, pn, grp = 0;
    if (AMODE == 0) {
      const int WGM = 8;
      int nig = WGM * nN, gid = tile / nig, fm = gid * WGM, gsz = min(nM - fm, WGM);
      pm = fm + ((tile % nig) % gsz); pn = (tile % nig) / gsz;
    } else { grp = tile / 9; pm = tile % 9; pn = 0; }
    T.brow = pm * TROWS; T.bcol = pn * BM; T.pn = pn; T.grp = grp;
    if (AMODE == 2) T.nt = 4;
    if (AMODE == 0) { T.Ab = ga.A + (long)T.brow * ga.lda + (long)kt0 * BK; T.Ab2 = nullptr; T.Bb = ga.Bt + (long)T.bcol * K + (long)kt0 * BK; }
    else { T.Ab = ga.A + ((long)grp * NCHR + T.brow) * 256; T.Ab2 = ga.A2 + ((long)grp * NCHR + T.brow) * 256; T.Bb = ga.Bt + (long)grp * 256 * K; }
  };
  GTile T, TN;
  auto a_base = [&](int h, int kt) -> const u16* {
    if (AMODE == 0) return T.Ab + (long)(h * HROWS) * ga.lda + (long)kt * BK;
    return T.Ab + (long)(h * HROWS) * 256 + kt * BK;
  };
#define PROLOGUE1() do { STB(SB(0, 0), 0, 0); STA(SA(0, 0), 0, 0); STB(SB(0, 1), 1, 0); STA(SA(0, 1), 1, 0); } while (0)
  int u = vb;
  if (u < nunits) { decode(u, T); PROLOGUE1(); }
  while (u < nunits) {
    const int nt = T.nt;
    f32x4 acc[2][2][MT][2] = {};
    bf16x8 At[MT][2], B0[2][2], B1[2][2];
#pragma unroll 1
    for (int pass = 0; pass < (AMODE == 2 ? 2 : 1); ++pass) {
    if (AMODE == 2 && pass == 1) { T.Ab = T.Ab2; T.Bb += 4 * BK; PROLOGUE1(); }
    if (wr == 1) BAR;
    WAIT_V(4); BAR;
    STB(SB(1, 0), 0, 1); STA(SA(1, 0), 0, 1); STB(SB(1, 1), 1, 1);
    WAIT_V(6); BAR;
    for (int t = 0; t < nt - 2; t += 2) {
      LDB(B0, 0, 0); SCHED; LDA(At, 0, 0); STA(SA(1, 1), 1, t + 1);
      WAIT_L(8); BAR; WAIT_L(0); MMA(0, 0, At, B0); BAR; SCHED;
      LDB(B1, 0, 1); STB(SB(0, 0), 0, t + 2);
      BAR; WAIT_L(0); MMA(0, 1, At, B1); BAR;
      LDA(At, 0, 1); STA(SA(0, 0), 0, t + 2);
      BAR; WAIT_L(0); MMA(1, 0, At, B0); BAR; SCHED;
      STB(SB(0, 1), 1, t + 2);
      WAIT_V(6); BAR; MMA(1, 1, At, B1); BAR;
      LDB(B0, 1, 0); SCHED; LDA(At, 1, 0); STA(SA(0, 1), 1, t + 2);
      WAIT_L(8); BAR; WAIT_L(0); MMA(0, 0, At, B0); BAR; SCHED;
      LDB(B1, 1, 1); STB(SB(1, 0), 0, t + 3);
      BAR; WAIT_L(0); MMA(0, 1, At, B1); BAR;
      LDA(At, 1, 1); STA(SA(1, 0), 0, t + 3);
      BAR; WAIT_L(0); MMA(1, 0, At, B0); BAR; SCHED;
      STB(SB(1, 1), 1, t + 3);
      WAIT_V(6); BAR; MMA(1, 1, At, B1); BAR;
    }
    { LDB(B0, 0, 0); LDA(At, 0, 0); STA(SA(1, 1), 1, nt - 1);
      BAR; WAIT_L(0); MMA(0, 0, At, B0); BAR;
      LDB(B1, 0, 1); BAR; WAIT_L(0); MMA(0, 1, At, B1); BAR;
      LDA(At, 0, 1); WAIT_V(4); BAR; WAIT_L(0); MMA(1, 0, At, B0); MMA(1, 1, At, B1); BAR; }
    { LDB(B0, 1, 0); LDA(At, 1, 0); WAIT_V(2); BAR; WAIT_L(0); MMA(0, 0, At, B0); BAR;
      LDB(B1, 1, 1); WAIT_V(0); BAR; WAIT_L(0); MMA(0, 1, At, B1); BAR;
      LDA(At, 1, 1); BAR; WAIT_L(0); MMA(1, 0, At, B0); MMA(1, 1, At, B1); BAR; }
    if (wr == 0) BAR;
    }
    const int brow = T.brow, bcol = T.bcol, pn = T.pn, grp = T.grp, split = T.split;
    const int un = u + G;
    if (un < nunits) { decode(un, TN); T = TN; PROLOGUE1(); }
    u = un;

    gemm_epilogue<EPI, MT>(p, ga, acc, brow, bcol, pn, grp);
  }
  WAIT_V(0);
#undef SA
#undef SB
}

template <int EPI, int MT, int GMODE = 0>
DI void gemm_sp2(const Params& p, const GemmArgs& ga) {
  constexpr int MROWS = MT * 16, HROWS = 2 * MROWS, TROWS = 2 * HROWS;
  extern __shared__ __attribute__((aligned(16))) __hip_bfloat16 shm[];
#define XSA(b, h) ((char*)shm + ((b) * 2 + (h)) * (HT * 2))
#define XSB(b, h) ((char*)shm + (4 + (b) * 2 + (h)) * (HT * 2))
#define XGL(src, dst) __builtin_amdgcn_global_load_lds((const unsigned*)(src), (unsigned*)(dst), 16, 0, 0)
#define XSTA(P, base) do { const char* _s = (base); XGL(_s + (size_t)offA, (P) + wsid * 1024); XGL(_s + skipA + (size_t)offA, (P) + wsid * 1024 + 8192); } while (0)
#define XSTB(P, base) do { const char* _s = (base); XGL(_s + (size_t)offB, (P) + wsid * 1024); XGL(_s + skipB + (size_t)offB, (P) + wsid * 1024 + 8192); } while (0)
#define XLDA(dst, b, h) UNR for (int m = 0; m < MT; ++m) UNR for (int k = 0; k < 2; ++k) \
    dst[m][k] = *reinterpret_cast<const bf16x8*>(XSA(b, h) + lds_byte(wr * MROWS + m * 16 + fr, k * 32 + fq * 8))
#define XLDB(dst, b, h) UNR for (int n = 0; n < 2; ++n) UNR for (int k = 0; k < 2; ++k) \
    dst[n][k] = *reinterpret_cast<const bf16x8*>(XSB(b, h) + lds_byte(wc * 32 + n * 16 + fr, k * 32 + fq * 8))
#define XMMA(ai, bj, Af, Bf) do { __builtin_amdgcn_s_setprio(1); \
    UNR for (int m = 0; m < MT; ++m) UNR for (int n = 0; n < 2; ++n) UNR for (int k = 0; k < 2; ++k) \
      acc[ai][bj][m][n] = __builtin_amdgcn_mfma_f32_16x16x32_bf16(Bf[n][k], Af[m][k], acc[ai][bj][m][n], 0, 0, 0); \
    __builtin_amdgcn_s_setprio(0); } while (0)
  constexpr int NPASS = GMODE == 2 ? 2 : 1;
  const int K = ga.K, nM = ga.nM, nN = ga.nN, nt = GMODE ? 4 : K / BK, G = gridDim.x;
  const int sub = ga.sub > 0 ? ga.sub : 1;
  const int nunits = GMODE ? 64 * nM : (ga.ucount > 0 ? ga.ucount : nM * nN);
  const int lda = GMODE ? 256 : ga.lda;
  const int tidx = opaque_tid();
  const int wsid = __builtin_amdgcn_readfirstlane((int)threadIdx.x >> 6);
  const int wid = tidx >> 6, lane = tidx & 63, wr = wid >> 2, wc = wid & 3, fr = lane & 15, fq = lane >> 4;
  unsigned offA, offB;
  { int R0, C0; stage_rc(tidx * 16, R0, C0); offA = (R0 * lda + C0) * 2; offB = (R0 * K + C0) * 2; }
  const long skipA = (long)lda * 128, skipB = (long)K * 128;
  const long hstepA = (long)HROWS * lda * 2, hstepB = (long)HALF * K * 2;
  const long kstep = BK * 2;
  int vb = blockIdx.x;
  if ((G & 7) == 0) vb = (blockIdx.x & 7) * (G >> 3) + (blockIdx.x >> 3);
  struct XU { int brow, bcol, pn, grp; const char *cA, *cB; };
  auto decode = [&](int tile, int pass, XU& T) {
    if (GMODE == 0) {
      const int WGM = 8;
      const int part = tile % sub; tile = ga.tbase + tile / sub;
      int nig = WGM * nN, gid = tile / nig, fm = gid * WGM, gsz = min(nM - fm, WGM);
      int pm = fm + ((tile % nig) % gsz), pn = (tile % nig) / gsz;
      if (ga.rev) pm = nM - 1 - pm;
      T.brow = pm * (TROWS * sub) + part * TROWS; T.bcol = pn * BM; T.pn = pn; T.grp = 0;
      T.cA = (const char*)ga.A + (long)T.brow * lda * 2; T.cB = (const char*)ga.Bt + (long)T.bcol * K * 2;
    } else {
      int grp = tile / nM, pm = tile % nM;
      T.brow = pm * TROWS; T.bcol = 0; T.pn = 0; T.grp = grp;
      T.cA = (const char*)(pass == 0 ? ga.A : ga.A2) + ((long)grp * NCHR + T.brow) * 256 * 2;
      T.cB = (const char*)ga.Bt + ((long)grp * 256 * K + pass * 256) * 2;
    }
  };
  int u = vb, pass = 0;
  if (u >= nunits) return;
  XU cur, nxt;
  decode(u, 0, cur);
  const char* cA = cur.cA; const char* cB = cur.cB;
  f32x4 acc[2][2][MT][2] = {};
  bf16x8 At[MT][2], B0[2][2], B1[2][2];
  XSTB(XSB(0, 0), cB); XSTB(XSB(0, 1), cB + hstepB); XSTA(XSA(0, 0), cA); XSTA(XSA(0, 1), cA + hstepA);
  if (wr == 1) BAR;
  WAIT_V(2); BAR;
  XSTB(XSB(1, 0), cB + kstep); XSTA(XSA(1, 0), cA + kstep); XSTB(XSB(1, 1), cB + hstepB + kstep);
  WAIT_V(6); BAR;
  for (;;) {
    int un = u, npass = pass + 1;
    if (npass == NPASS) { npass = 0; un = u + G; }
    const bool has_next = un < nunits, fin = (pass == NPASS - 1);
    if (has_next) decode(un, npass, nxt);
    const char* nA = has_next ? nxt.cA : cA; const char* nB = has_next ? nxt.cB : cB;
    for (int t = 0; t < nt; t += 2) {
      const bool last = (t == nt - 2);
      const char* a1 = cA + (long)(t + 1) * kstep;
      const char* a2 = last ? nA : cA + (long)(t + 2) * kstep; const char* b2 = last ? nB : cB + (long)(t + 2) * kstep;
      const char* a3 = a2 + kstep; const char* b3 = b2 + kstep;
      XLDB(B0, 0, 0); XLDB(B1, 0, 1); SCHED; XLDA(At, 0, 0); XSTA(XSA(1, 1), a1 + hstepA);
      WAIT_V(8); WAIT_L(0); BAR; XMMA(0, 0, At, B0); XMMA(0, 1, At, B1); BAR; SCHED;
      XLDA(At, 0, 1); XSTB(XSB(0, 0), b2); XSTB(XSB(0, 1), b2 + hstepB); XSTA(XSA(0, 0), a2);
      WAIT_V(8); WAIT_L(0); BAR; XMMA(1, 0, At, B0); XMMA(1, 1, At, B1); BAR; SCHED;
      XLDB(B0, 1, 0); XLDB(B1, 1, 1); SCHED; XLDA(At, 1, 0); XSTA(XSA(0, 1), a2 + hstepA);
      WAIT_V(8); WAIT_L(0); BAR; XMMA(0, 0, At, B0); XMMA(0, 1, At, B1); BAR; SCHED;
      XLDA(At, 1, 1); XSTB(XSB(1, 0), b3); XSTB(XSB(1, 1), b3 + hstepB); XSTA(XSA(1, 0), a3);
      WAIT_V(8); WAIT_L(0); BAR; XMMA(1, 0, At, B0); XMMA(1, 1, At, B1); BAR; SCHED;
    }
    if (fin) {
      if (wr == 0) BAR;
      gemm_epilogue<EPI, MT>(p, ga, acc, cur.brow, cur.bcol, cur.pn, cur.grp);
    }
    if (!has_next) break;
    if (fin) { UNR for (int a = 0; a < 2; ++a) UNR for (int b = 0; b < 2; ++b) UNR for (int m = 0; m < MT; ++m) UNR for (int n = 0; n < 2; ++n) acc[a][b][m][n] = (f32x4){0.f, 0.f, 0.f, 0.f}; }
    cur = nxt; cA = nA; cB = nB; u = un; pass = npass;
    if (fin && wr == 1) BAR;
  }
  WAIT_V(0);
  BAR;
#undef XSA
#undef XSB
}

#define MFMA32(a, b, c) __builtin_amdgcn_mfma_f32_32x32x16_bf16((a), (b), (c), 0, 0, 0)

struct KVTile { bf16x8 k[4]; bf16x8 v[2][2]; };
constexpr int AT_ROW = 144, AT_KB = 64 * AT_ROW, AT_STAGE = 2 * AT_KB;

DI void read_kv(KVTile& t, const char* kbuf, const char* vbuf, int sb, int l32, int h) {
  const int kperm = (l32 & ~12) | ((l32 & 4) << 1) | ((l32 & 8) >> 1);
  const char* kp = kbuf + (sb * 32 + kperm) * AT_ROW + h * 64;
#pragma unroll
  for (int kk = 0; kk < 4; ++kk) t.k[kk] = *reinterpret_cast<const bf16x8*>(kp + kk * 16);
#pragma unroll
  for (int dt = 0; dt < 2; ++dt)
#pragma unroll
    for (int k2 = 0; k2 < 2; ++k2)
      t.v[dt][k2] = *reinterpret_cast<const bf16x8*>(vbuf + (dt * 32 + l32) * AT_ROW + sb * 64 + k2 * 32 + h * 16);
}

template <bool MASK>
DI void attn_tile(const KVTile& t, const bf16x8 (&q)[2][4], f32x16 (&O)[2][2], float (&mrow)[2], float (&lrow)[2],
                  int k0, int q0w, int l32, int h, float c1) {
#pragma unroll
  for (int qt = 0; qt < 2; ++qt) {
    const int q0t = q0w + qt * 32;
    bool need_mask = false;
    if (MASK) {
      if (k0 + 31 < q0t - 128 || k0 > q0t + 31 + 128) continue;
      need_mask = (q0t + 31 - k0 > 128) || (k0 + 31 - q0t > 128);
    }
    f32x16 S;
#pragma unroll
    for (int i = 0; i < 16; ++i) S[i] = 0.f;
#pragma unroll
    for (int kk = 0; kk < 4; ++kk) S = MFMA32(t.k[kk], q[qt][kk], S);
    if (MASK && need_mask) {
      const int base = q0t + l32 - k0 - 8 * h + 128;
#pragma unroll
      for (int r = 0; r < 16; ++r) {
        unsigned d = (unsigned)(base - (16 * (r >> 3) + (r & 7)));
        if (d > 256u) S[r] = -1.0e30f;
      }
    }
    float mx = S[0];
#pragma unroll
    for (int r = 1; r < 16; ++r) mx = fmaxf(mx, S[r]);
    mx = xhalf_max(mx);
    const float mold = mrow[qt];
    const float cand = mx * c1;
    const float mnew = cand > mold + 8.f ? cand : mold;
    mrow[qt] = mnew;
    hwf32x2 rs2 = {0.f, 0.f};
    const hwf32x2 c2 = {c1, c1}, nm2 = {-mnew, -mnew};
#pragma unroll
    for (int r = 0; r < 16; r += 2) {
      hwf32x2 sv = {S[r], S[r + 1]};
      sv = __builtin_elementwise_fma(sv, c2, nm2);
      hwf32x2 pv = {__builtin_amdgcn_exp2f(sv.x), __builtin_amdgcn_exp2f(sv.y)};
      S[r] = pv.x; S[r + 1] = pv.y; rs2 += pv;
    }
    float rs = xhalf_sum(rs2.x + rs2.y);
    if (__ballot(mnew != mold) != 0) {
      const float alpha = __builtin_amdgcn_exp2f(mold - mnew);
      lrow[qt] *= alpha;
#pragma unroll
      for (int dt = 0; dt < 2; ++dt)
#pragma unroll
        for (int r = 0; r < 16; ++r) O[qt][dt][r] *= alpha;
    }
    lrow[qt] += rs;
    bf16x8 pk[2];
#pragma unroll
    for (int k2 = 0; k2 < 2; ++k2) {
      uint4 u;
      u.x = pack2(S[8 * k2 + 0], S[8 * k2 + 1]); u.y = pack2(S[8 * k2 + 2], S[8 * k2 + 3]);
      u.z = pack2(S[8 * k2 + 4], S[8 * k2 + 5]); u.w = pack2(S[8 * k2 + 6], S[8 * k2 + 7]);
      pk[k2] = __builtin_bit_cast(bf16x8, u);
    }
#pragma unroll
    for (int dt = 0; dt < 2; ++dt)
#pragma unroll
      for (int k2 = 0; k2 < 2; ++k2) O[qt][dt] = MFMA32(t.v[dt][k2], pk[k2], O[qt][dt]);
  }
}

DI void attn_phase(const Params& p, int a) {
  extern __shared__ __attribute__((aligned(16))) __hip_bfloat16 shm[];
  char* lds = (char*)shm;
  const u16* Q = (const u16*)(p.ws + OFF_R1 + R1_Q); const u16* KB = (const u16*)(p.ws + OFF_R1 + R1_KB);
  const u16* VT = (const u16*)(p.ws + OFF_R1 + R1_VT); u16* Og = (u16*)(p.ws + OFF_R1 + R1_O);
  const u16* KC = (const u16*)(p.ws + OFF_KC); const u16* VTC = (const u16*)(p.ws + OFF_VTC);
  const float* rope = (const float*)(p.ws + OFF_ROPE);
  const int tidx = opaque_tid();
  const int wid = tidx >> 6, lane = tidx & 63, l32 = lane & 31, h = lane >> 5;
  const int grow = tidx >> 3, gc = tidx & 7;
  const float LOG2E = 1.4426950408889634f, c1 = 0.125f * LOG2E;
  for (int it = blockIdx.x; it < 1152; it += gridDim.x) {
    const bool lat = it < 1024;
    int seq, qblk, kvh;
    if (lat) { kvh = it & 3; qblk = (it >> 2) & 31; seq = it >> 7; } else { int j = it - 1024; kvh = j & 3; qblk = (j >> 2) & 1; seq = j >> 3; }
    const int head = kvh * 4 + (wid >> 1);
    const int qb0 = qblk * 128, q0 = qb0 + (wid & 1) * 64;
    const long rowbase = lat ? (long)MCTX + (long)seq * 4096 : (long)seq * 256;
    const u16 *KbA, *VbA; long vsA; int nA;
    if (lat) { KbA = KC + ((long)(seq * 2 + a) * 512) * 256 + kvh * 64; VbA = VTC + ((long)(seq * 2 + a) * 256 + kvh * 64) * 512; vsA = 512; nA = 8; }
    else { KbA = KB + rowbase * 256 + kvh * 64; VbA = VT + ((long)seq * 256 + kvh * 64) * 256; vsA = 256; nA = 4; }
    const u16* KbB = KB + rowbase * 256 + kvh * 64;
    const u16* VbB = VT + (long)16 * 256 * 256 + ((long)seq * 256 + kvh * 64) * 4096;
    const int m0 = qblk == 0 ? 2 : 0, m1 = lat ? (qblk == 31 ? 4 : 6) : 0;
    const int nS = nA + (lat ? m1 - m0 : 0);
    auto issue = [&](int j, uint4& kreg, uint4& vreg) {
      if (j < nA) {
        int key0 = j * 64;
        kreg = *reinterpret_cast<const uint4*>(KbA + (long)(key0 + grow) * 256 + gc * 8);
        vreg = *reinterpret_cast<const uint4*>(VbA + (long)grow * vsA + key0 + gc * 8);
      } else {
        int key0 = qb0 - 128 + (j - nA + m0) * 64;
        kreg = *reinterpret_cast<const uint4*>(KbB + (long)(key0 + grow) * 256 + gc * 8);
        vreg = *reinterpret_cast<const uint4*>(VbB + (long)grow * 4096 + key0 + gc * 8);
      }
    };
    uint4 kreg, vreg;
    issue(0, kreg, vreg);
    bf16x8 q[2][4];
#pragma unroll
    for (int qt = 0; qt < 2; ++qt) {
      const uint4* qp = reinterpret_cast<const uint4*>(Q + (rowbase + q0 + qt * 32 + l32) * 1024 + head * 64 + h * 32);
#pragma unroll
      for (int kk = 0; kk < 4; ++kk) q[qt][kk] = __builtin_bit_cast(bf16x8, qp[kk]);
    }
    const float sk = p.sink[a * 16 + head] * LOG2E;
    float mrow[2] = {sk, sk}, lrow[2] = {1.f, 1.f};
    f32x16 O[2][2];
#pragma unroll
    for (int qt = 0; qt < 2; ++qt)
#pragma unroll
      for (int dt = 0; dt < 2; ++dt)
#pragma unroll
        for (int r = 0; r < 16; ++r) O[qt][dt][r] = 0.f;
    *reinterpret_cast<uint4*>(lds + grow * AT_ROW + gc * 16) = kreg;
    *reinterpret_cast<uint4*>(lds + AT_KB + grow * AT_ROW + gc * 16) = vreg;
    __syncthreads();
#define ATT_STAGE_BEGIN const char* kbuf = lds + (j & 1) * AT_STAGE; const char* vbuf = kbuf + AT_KB; if (j + 1 < nS) issue(j + 1, kreg, vreg);
#define ATT_STAGE_END if (j + 1 < nS) { char* nb = lds + ((j + 1) & 1) * AT_STAGE; \
        *reinterpret_cast<uint4*>(nb + grow * AT_ROW + gc * 16) = kreg; *reinterpret_cast<uint4*>(nb + AT_KB + grow * AT_ROW + gc * 16) = vreg; } \
      __syncthreads();
    for (int j = 0; j < nA; ++j) {
      ATT_STAGE_BEGIN
#pragma unroll
      for (int sb = 0; sb < 2; ++sb) {
        KVTile t; read_kv(t, kbuf, vbuf, sb, l32, h);
        attn_tile<false>(t, q, O, mrow, lrow, 0, 0, l32, h, c1);
      }
      ATT_STAGE_END
    }
    if (lat) {
#pragma unroll
      for (int qt = 0; qt < 2; ++qt) {
        int t = q0 + qt * 32 + l32; int pos = h ? (t & 63) : (t >> 6);
#pragma unroll
        for (int kk = 0; kk < 2; ++kk) {
          const float4* cs = reinterpret_cast<const float4*>(rope + (pos * 16 + kk * 8) * 2);
#pragma unroll
          for (int e2 = 0; e2 < 4; ++e2) {
            float4 c4 = cs[e2];
            float cA = c4.x, sA = c4.y, cB = c4.z, sB = c4.w;
            float x1 = bf2f((u16)q[qt][kk][2 * e2]), x2 = bf2f((u16)q[qt][kk + 2][2 * e2]);
            q[qt][kk][2 * e2] = (short)f2bf(x1 * cA - x2 * sA); q[qt][kk + 2][2 * e2] = (short)f2bf(x1 * sA + x2 * cA);
            x1 = bf2f((u16)q[qt][kk][2 * e2 + 1]); x2 = bf2f((u16)q[qt][kk + 2][2 * e2 + 1]);
            q[qt][kk][2 * e2 + 1] = (short)f2bf(x1 * cB - x2 * sB); q[qt][kk + 2][2 * e2 + 1] = (short)f2bf(x1 * sB + x2 * cB);
          }
        }
      }
      for (int j = nA; j < nS; ++j) {
        ATT_STAGE_BEGIN
        const int key0 = qb0 - 128 + (j - nA + m0) * 64;
#pragma unroll 1
        for (int sb = 0; sb < 2; ++sb) {
          const int k0 = key0 + sb * 32;
          if (k0 + 31 >= q0 - 128 && k0 <= q0 + 63 + 128) {
            KVTile t; read_kv(t, kbuf, vbuf, sb, l32, h);
            attn_tile<true>(t, q, O, mrow, lrow, k0, q0, l32, h, c1);
          }
        }
        ATT_STAGE_END
      }
    }
    {
      char* ost = lds + 40960 + wid * (64 * 144);
#pragma unroll
      for (int qt = 0; qt < 2; ++qt) {
        const float inv = __builtin_amdgcn_rcpf(lrow[qt]);
        char* orow = ost + (qt * 32 + l32) * 144 + 8 * h;
#pragma unroll
        for (int dt = 0; dt < 2; ++dt)
#pragma unroll
          for (int g4 = 0; g4 < 4; ++g4) {
            uint2 o; o.x = pack2(O[qt][dt][4 * g4] * inv, O[qt][dt][4 * g4 + 1] * inv);
            o.y = pack2(O[qt][dt][4 * g4 + 2] * inv, O[qt][dt][4 * g4 + 3] * inv);
            *reinterpret_cast<uint2*>(orow + dt * 64 + 16 * g4) = o;
          }
      }
      asm volatile("s_waitcnt lgkmcnt(0)" ::: "memory");
#pragma unroll
      for (int e = 0; e < 8; ++e) {
        const int gidx = lane + 64 * e, r = gidx >> 3, c = gidx & 7;
        uint4 v = *reinterpret_cast<const uint4*>(ost + r * 144 + c * 16);
        *reinterpret_cast<uint4*>(Og + (rowbase + q0 + r) * 1024 + head * 64 + c * 8) = v;
      }
      asm volatile("s_waitcnt lgkmcnt(0)" ::: "memory");
    }
  }
}

DI void row_phase(const Params& p, int mode, int ln_layer, int ln_idx, int mod_layer, int mod_idx) {
  const u16* X = (const u16*)(p.ws + OFF_X); u16* H = (u16*)(p.ws + OFF_H);
  const int tidx = opaque_tid();
  const int lane = tidx & 63, gw = blockIdx.x * 8 + (tidx >> 6), nw = gridDim.x * 8;
  float4 g4[4], b4[4];
  if (mode != 0) {
    const float* g = p.ln_g + (ln_layer * 2 + ln_idx) * 1024; const float* b = p.ln_b + (ln_layer * 2 + ln_idx) * 1024;
    UNR for (int j = 0; j < 4; ++j) { g4[j] = *reinterpret_cast<const float4*>(g + j * 256 + lane * 4); b4[j] = *reinterpret_cast<const float4*>(b + j * 256 + lane * 4); }
  }
  for (int row0 = gw * 2; row0 < MTOK; row0 += nw * 2) {
    float4 v[2][4];
    UNR for (int rr = 0; rr < 2; ++rr) {
      const int row = row0 + rr;
      if (mode == 0) {
        const float* src = row < MCTX ? p.x_prompt + (long)row * D : p.x_sample + (long)(row - MCTX) * D;
        UNR for (int j = 0; j < 4; ++j) v[rr][j] = nt_load_f4(src + j * 256 + lane * 4);
      } else {
        const u16* src = X + (long)row * D;
        UNR for (int j = 0; j < 4; ++j) {
          uint2 raw = nt_load_u2(src + j * 256 + lane * 4);
          v[rr][j] = make_float4(__uint_as_float(raw.x << 16), __uint_as_float(raw.x & 0xffff0000u), __uint_as_float(raw.y << 16), __uint_as_float(raw.y & 0xffff0000u));
        }
      }
    }
    UNR for (int rr = 0; rr < 2; ++rr) {
      const int row = row0 + rr;
      if (mode != 0) {
        float s = 0.f;
        UNR for (int j = 0; j < 4; ++j) s += v[rr][j].x + v[rr][j].y + v[rr][j].z + v[rr][j].w;
        float mu = wave_sum(s, lane) * (1.f / 1024.f);
        float q = 0.f;
        UNR for (int j = 0; j < 4; ++j) { v[rr][j].x -= mu; v[rr][j].y -= mu; v[rr][j].z -= mu; v[rr][j].w -= mu; q += v[rr][j].x * v[rr][j].x + v[rr][j].y * v[rr][j].y + v[rr][j].z * v[rr][j].z + v[rr][j].w * v[rr][j].w; }
        float rstd = rsqrtf(wave_sum(q, lane) * (1.f / 1024.f) + LN_EPS);
        if (mode == 1 && lane == 0) *reinterpret_cast<float2*>((float*)(p.ws + OFF_STATS) + (long)row * 2) = make_float2(mu, rstd);
        UNR for (int j = 0; j < 4; ++j) {
          v[rr][j].x = v[rr][j].x * rstd * g4[j].x + b4[j].x; v[rr][j].y = v[rr][j].y * rstd * g4[j].y + b4[j].y;
          v[rr][j].z = v[rr][j].z * rstd * g4[j].z + b4[j].z; v[rr][j].w = v[rr][j].w * rstd * g4[j].w + b4[j].w;
        }
      }
      if (mode == 2) {
        UNR for (int j = 0; j < 4; ++j) nt_store_f4(p.out + (long)row * D + j * 256 + lane * 4, v[rr][j]);
      } else {
        const int cond = cond_of_row(row);
        const float* sh = mods_ptr(p, mod_layer, cond, mod_idx); const float* sc = mods_ptr(p, mod_layer, cond, mod_idx + 1);
        UNR for (int j = 0; j < 4; ++j) {
          float4 s4 = *reinterpret_cast<const float4*>(sh + j * 256 + lane * 4), c4 = *reinterpret_cast<const float4*>(sc + j * 256 + lane * 4);
          uint2 o; o.x = pack2(v[rr][j].x * (1.f + c4.x) + s4.x, v[rr][j].y * (1.f + c4.y) + s4.y);
          o.y = pack2(v[rr][j].z * (1.f + c4.z) + s4.z, v[rr][j].w * (1.f + c4.w) + s4.w);
          *reinterpret_cast<uint2*>(H + (long)row * D + j * 256 + lane * 4) = o;
        }
      }
    }
  }
}

DI int prow(int n) { int a = n & 31; return (n & ~31) + ((a >> 2) & 1) * 16 + (a >> 3) * 4 + (a & 3); }
DI void sincos_red(float ang, float& s, float& c) {
  float n = rintf(ang * 0.15915494309189535f);
  float r = fmaf(-n, 6.2831854820251465f, ang);
  r = fmaf(-n, -1.7484555e-7f, r);
  s = __sinf(r); c = __cosf(r);
}

DI void ssm_prep(const Params& p, int s) {
  extern __shared__ __attribute__((aligned(16))) __hip_bfloat16 shm[];
  float* L = (float*)shm;
  float* ap_re = L;
  float* ap_im = ap_re + 2176;
  float* bb_re = ap_im + 2176;
  float* bb_im = bb_re + 2048;
  float* cc_re = bb_im + 2048;
  float* cc_im = cc_re + 2048;
  float* kmat = cc_im + 2048;
  u16* Pt = (u16*)(p.ws + OFF_PT); u16* Tt = (u16*)(p.ws + OFF_TT);
  const int tid = opaque_tid();
  for (int it = blockIdx.x; it < 256; it += gridDim.x) {
    const int g = it >> 2, qr = it & 3;
    __syncthreads();
    if (tid < 128) {
      int dir = tid >> 6, pp = tid & 63;
      long li = ((long)(s * 2 + dir) * 64 + g) * 64 + pp;
      float lr = p.lam_re[li], lim = p.lam_im[li];
      float dt = __expf(p.log_dt[(s * 2 + dir) * 64 + g]);
      for (int j = 0; j <= 16; ++j) {
        float mag = __expf((float)j * lr * dt), sn, cs;
        sincos_red((float)j * lim * dt, sn, cs);
        ap_re[(dir * 64 + pp) * 17 + j] = mag * cs; ap_im[(dir * 64 + pp) * 17 + j] = mag * sn;
      }
      float ar = ap_re[(dir * 64 + pp) * 17 + 1], ai = ap_im[(dir * 64 + pp) * 17 + 1];
      float den = lr * lr + lim * lim, nr = ar - 1.f, ni = ai;
      float cr = (nr * lr + ni * lim) / den, ci = (ni * lr - nr * lim) / den;
      for (int m = 0; m < 16; ++m) {
        float br = p.b_re[li * 16 + m], bi = p.b_im[li * 16 + m];
        bb_re[(dir * 64 + pp) * 16 + m] = cr * br - ci * bi; bb_im[(dir * 64 + pp) * 16 + m] = cr * bi + ci * br;
      }
    }
    for (int i = tid; i < 2048; i += 512) {
      int dir = i >> 10, r = i & 1023;
      long ci = ((long)(s * 2 + dir) * 64 + g) * 1024 + r;
      cc_re[i] = p.c_re[ci]; cc_im[i] = p.c_im[ci];
    }
    __syncthreads();
    {
      int dir = tid >> 8, j = (tid >> 4) & 15, m = tid & 15;
      float acc[16];
#pragma unroll
      for (int i = 0; i < 16; ++i) acc[i] = 0.f;
      for (int pp = 0; pp < 64; ++pp) {
        float cr = cc_re[(dir * 16 + m) * 64 + pp], ci = cc_im[(dir * 16 + m) * 64 + pp];
        float ar = ap_re[(dir * 64 + pp) * 17 + j], ai = ap_im[(dir * 64 + pp) * 17 + j];
        float xr = cr * ar - ci * ai, xi = cr * ai + ci * ar;
#pragma unroll
        for (int i = 0; i < 16; ++i) acc[i] += xr * bb_re[(dir * 64 + pp) * 16 + i] - xi * bb_im[(dir * 64 + pp) * 16 + i];
      }
#pragma unroll
      for (int i = 0; i < 16; ++i) kmat[((dir * 16 + j) * 16 + m) * 16 + i] = acc[i];
    }
    __syncthreads();
    for (int gi = tid; gi < 64 * 64; gi += 512) {
      int n = qr * 64 + (gi >> 6), k0 = (gi & 63) * 8, tau = n >> 4, m = n & 15;
      float v[8];
      if (k0 < 256) {
        int sg = k0 >> 4, mp0 = k0 & 15;
#pragma unroll
        for (int e = 0; e < 8; ++e) {
          int mp = mp0 + e; float x = 0.f;
          if (sg <= tau) x += kmat[((0 * 16 + (tau - sg)) * 16 + m) * 16 + mp];
          if (sg >= tau) x += kmat[((1 * 16 + (sg - tau)) * 16 + m) * 16 + mp];
          if (sg == tau && mp == m) x += p.ssm_d[s * 1024 + g * 16 + m];
          v[e] = x;
        }
      } else {
        int qq = k0 - 256, dir = qq >> 7, p0 = (qq & 127) >> 1;
        int ex = dir == 0 ? tau + 1 : 16 - tau;
#pragma unroll
        for (int e2 = 0; e2 < 4; ++e2) {
          int pp = p0 + e2;
          float cr = cc_re[(dir * 16 + m) * 64 + pp], ci = cc_im[(dir * 16 + m) * 64 + pp];
          float ar = ap_re[(dir * 64 + pp) * 17 + ex], ai = ap_im[(dir * 64 + pp) * 17 + ex];
          v[2 * e2] = cr * ar - ci * ai; v[2 * e2 + 1] = -(cr * ai + ci * ar);
        }
      }
      uint4 o; o.x = pack2(v[0], v[1]); o.y = pack2(v[2], v[3]); o.z = pack2(v[4], v[5]); o.w = pack2(v[6], v[7]);
      *reinterpret_cast<uint4*>(Tt + ((long)g * 256 + prow(n)) * 512 + k0) = o;
    }
    for (int gi = tid; gi < 64 * 32; gi += 512) {
      int n = qr * 64 + (gi >> 5), k0 = (gi & 31) * 8, dir = n >> 7, pp = (n & 127) >> 1, ri = n & 1;
      int sg = k0 >> 4, mp0 = k0 & 15, ex = dir == 0 ? 15 - sg : sg;
      float ar = ap_re[(dir * 64 + pp) * 17 + ex], ai = ap_im[(dir * 64 + pp) * 17 + ex];
      float v[8];
#pragma unroll
      for (int e = 0; e < 8; ++e) {
        float br = bb_re[(dir * 64 + pp) * 16 + mp0 + e], bi = bb_im[(dir * 64 + pp) * 16 + mp0 + e];
        v[e] = ri ? (ar * bi + ai * br) : (ar * br - ai * bi);
      }
      uint4 o; o.x = pack2(v[0], v[1]); o.y = pack2(v[2], v[3]); o.z = pack2(v[4], v[5]); o.w = pack2(v[6], v[7]);
      *reinterpret_cast<uint4*>(Pt + ((long)g * 256 + prow(n)) * 256 + k0) = o;
    }
  }
  __syncthreads();
}

struct ConvDesc { const float* src; u16* dst; int ld, K, N, mode, tstart, tend; };
DI void conv_table(const Params& p, int l, ConvDesc* tab, int* cnt, int zz) {
  char* ws = p.ws;
  const int a = l >> 1;
  int n = 0, ts = zz;
  auto add = [&](const float* src, u16* dst, int ld, int K, int N, int mode) {
    ConvDesc d; d.src = src; d.dst = dst; d.ld = ld + zz; d.K = K + zz; d.N = N + zz; d.mode = mode + zz; d.tstart = ts; ts += (K >> 6) * (N >> 6); d.tend = ts;
    tab[n++] = d;
  };
  if ((l & 1) == 0) {
    add(p.w_qkv + (long)a * 1024 * 1536, (u16*)(ws + OFF_WA), 1536, 1024, 1536, 3);
    add(p.w_o + (long)a * 1024 * 1024, (u16*)(ws + OFF_WB), 1024, 1024, 1024, 0);
  } else {
    add(p.ssm_w_in + (long)a * 1024 * 1024, (u16*)(ws + OFF_WA), 1024, 1024, 1024, 0);
    add(p.w_out + (long)a * 1024 * 1024, (u16*)(ws + OFF_WB), 1024, 1024, 1024, 0);
    add(p.w_glu + (long)a * 1024 * 2048, (u16*)(ws + OFF_WGLU), 2048, 1024, 1024, 1);
    add(p.w_glu + (long)a * 1024 * 2048 + 1024, (u16*)(ws + OFF_WGLU), 2048, 1024, 1024, 2);
  }
  add(p.w1 + (long)l * 1024 * DFF, (u16*)(ws + OFF_W13), DFF, 1024, DFF, 1);
  add(p.w3 + (long)l * 1024 * DFF, (u16*)(ws + OFF_W13), DFF, 1024, DFF, 2);
  add(p.w2 + (long)l * DFF * 1024, (u16*)(ws + OFF_W2), 1024, DFF, 1024, 0);
  *cnt = n;
}

DI void conv_layer(const Params& p, int l) {
  extern __shared__ __attribute__((aligned(16))) __hip_bfloat16 shm[];
  float* lds = (float*)shm;
  ConvDesc* tab = (ConvDesc*)((char*)shm + 4 * 64 * 65 * 4);
  int* cntp = (int*)((char*)shm + 4 * 64 * 65 * 4 + 8 * sizeof(ConvDesc));
  const int tidc = opaque_tid();
  int nb = gridDim.x, bid = blockIdx.x;
  __syncthreads();
  int zz = 0; asm volatile("" : "+s"(zz));
  if (tidc == 0) conv_table(p, l, tab, cntp, zz);
  __syncthreads();
  const int cnt = *cntp, total = tab[cnt - 1].tend;
  auto find = [&](int gt) -> int { int i = 0; while (i < cnt - 1 && gt >= tab[i].tend) ++i; return i; };
  auto issue = [&](int gt, float (&r)[8]) {
    const int i = find(gt);
    const float* src = tab[i].src; const int ld = tab[i].ld, tnn = tab[i].N >> 6, t = gt - tab[i].tstart, kt = t / tnn, nt = t % tnn;
    UNR for (int e = 0; e < 8; ++e) { int idx = tidc + 512 * e, kk = idx >> 6, nn = idx & 63; r[e] = __builtin_nontemporal_load(src + (long)(kt * 64 + kk) * ld + nt * 64 + nn); }
  };
  auto emit = [&](int gt, const float* L) {
    const int i = find(gt);
    u16* dst = tab[i].dst; const int K = tab[i].K, mode = tab[i].mode, tnn = tab[i].N >> 6, t = gt - tab[i].tstart, kt = t / tnn, nt = t % tnn;
    int n = tidc >> 3, k8 = (tidc & 7) * 8, ng = nt * 64 + n;
    const int a32 = ng & 31, pa = ((a32 >> 2) & 1) * 16 + (a32 >> 3) * 4 + (a32 & 3);
    int nr = (mode == 1 || mode == 2) ? ((ng >> 7) * 256 + (mode == 2 ? 128 : 0) + (ng & 96) + pa)
                                      : ((mode == 0 || ng < 1024) ? (ng & ~31) + pa : ng);
    uint4 o;
    o.x = pack2(L[(k8 + 0) * 65 + n], L[(k8 + 1) * 65 + n]); o.y = pack2(L[(k8 + 2) * 65 + n], L[(k8 + 3) * 65 + n]);
    o.z = pack2(L[(k8 + 4) * 65 + n], L[(k8 + 5) * 65 + n]); o.w = pack2(L[(k8 + 6) * 65 + n], L[(k8 + 7) * 65 + n]);
    *reinterpret_cast<uint4*>(dst + (long)nr * K + kt * 64 + k8) = o;
  };
  float r0[8], r1[8];
  int gt = 2 * bid, buf = 0;
  if (gt < total) issue(gt, r0);
  if (gt + 1 < total) issue(gt + 1, r1);
  for (; gt < total; gt += 2 * nb) {
    float* L0 = lds + buf * (2 * 64 * 65); float* L1 = L0 + 64 * 65;
    const bool two = gt + 1 < total;
    UNR for (int e = 0; e < 8; ++e) { int idx = tidc + 512 * e, kk = idx >> 6, nn = idx & 63; L0[kk * 65 + nn] = r0[e]; if (two) L1[kk * 65 + nn] = r1[e]; }
    if (gt + 2 * nb < total) issue(gt + 2 * nb, r0);
    if (gt + 2 * nb + 1 < total) issue(gt + 2 * nb + 1, r1);
    __syncthreads();
    emit(gt, L0);
    if (two) emit(gt + 1, L1);
    buf ^= 1;
  }
  if (l & 1) { __syncthreads(); ssm_prep(p, l >> 1); }
}

DI void prep_phase(const Params& p) {
  extern __shared__ __attribute__((aligned(16))) __hip_bfloat16 shm[];
  float* L = (float*)shm;
  const int tid = opaque_tid();
  for (int it = blockIdx.x; it < 192; it += gridDim.x) {
    float* sc = L;
    float* red = L + 9216;
    __syncthreads();
    for (int i = tid; i < 9216; i += 512) {
      int cd = i >> 10, k = i & 1023;
      float v = cd == 0 ? p.c_ctx[k] : p.c[(cd - 1) * 1024 + k];
      sc[i] = v * fast_sigmoid(v);
    }
    __syncthreads();
    const int cg4 = tid & 31, ks = tid >> 5;
    const int cidx = it * 128 + cg4 * 4, l = cidx / 6144, col = cidx % 6144;
    const float* w = p.w_ada + ((long)l * 1024 + ks * 64) * 6144 + col;
    float acc[9][4];
#pragma unroll
    for (int i = 0; i < 9; ++i) { acc[i][0] = 0.f; acc[i][1] = 0.f; acc[i][2] = 0.f; acc[i][3] = 0.f; }
#pragma unroll 8
    for (int k = 0; k < 64; ++k) {
      float4 wv = nt_load_f4(w + (long)k * 6144);
#pragma unroll
      for (int i = 0; i < 9; ++i) { float sv = sc[i * 1024 + ks * 64 + k]; acc[i][0] += sv * wv.x; acc[i][1] += sv * wv.y; acc[i][2] += sv * wv.z; acc[i][3] += sv * wv.w; }
    }
#pragma unroll
    for (int i = 0; i < 9; ++i) *reinterpret_cast<float4*>(red + (ks * 9 + i) * 128 + cg4 * 4) = make_float4(acc[i][0], acc[i][1], acc[i][2], acc[i][3]);
    __syncthreads();
    if (tid < 128) {
      const int c1 = it * 128 + tid, l1 = c1 / 6144, col1 = c1 % 6144;
      float bia = p.b_ada[l1 * 6144 + col1];
      float* mo = (float*)(p.ws + OFF_MODS);
#pragma unroll
      for (int i = 0; i < 9; ++i) {
        float v = bia;
#pragma unroll
        for (int k2 = 0; k2 < 16; ++k2) v += red[(k2 * 9 + i) * 128 + tid];
        mo[((long)(l1 * 9 + i)) * 6144 + col1] = v;
      }
    }
    __syncthreads();
  }
  if (blockIdx.x == gridDim.x - 1) {
    float* rope = (float*)(p.ws + OFF_ROPE);
    for (int i = tid; i < 1024; i += 512) {
      int pos = i >> 4, f = i & 15;
      float inv = exp2f(-(float)f * (13.287712379549449f / 16.f));
      float sn, cs; sincos_red((float)pos * inv, sn, cs);
      rope[i * 2] = cs; rope[i * 2 + 1] = sn;
    }
  }
  {
    u16* KC = (u16*)(p.ws + OFF_KC); u16* VTC = (u16*)(p.ws + OFF_VTC);
    const long nthr = (long)gridDim.x * 512, gt = (long)blockIdx.x * 512 + tid;
    for (long i = gt; i < 2097152 / 4; i += nthr) {
      float4 v = *reinterpret_cast<const float4*>(p.cache_k + i * 4);
      uint2 o; o.x = pack2(v.x, v.y); o.y = pack2(v.z, v.w);
      *reinterpret_cast<uint2*>(KC + i * 4) = o;
    }
    for (long i = gt; i < 16L * 64 * 256; i += nthr) {
      int col = (int)(i & 255), kg = (int)((i >> 8) & 63), ba = (int)(i >> 14);
      const float* src = p.cache_v + ((long)ba * 512 + kg * 8) * 256 + col;
      float v[8];
#pragma unroll
      for (int e = 0; e < 8; ++e) v[e] = src[e * 256];
      uint4 o; o.x = pack2(v[0], v[1]); o.y = pack2(v[2], v[3]); o.z = pack2(v[4], v[5]); o.w = pack2(v[6], v[7]);
      *reinterpret_cast<uint4*>(VTC + ((long)ba * 256 + col) * 512 + kg * 8) = o;
    }
  }
  __syncthreads();
  conv_layer(p, 0);
}

DI void scan_phase(const Params& p, int s) {
  const u16* S = (const u16*)(p.ws + OFF_R1 + R1_S);
  u16* Hin = (u16*)(p.ws + OFF_H);
  const int tidx = opaque_tid();
  const int lane = tidx & 63, gw = blockIdx.x * 8 + (tidx >> 6), nw = gridDim.x * 8;
  for (int it = gw; it < 3072; it += nw) {
    const bool lat = it < 1024;
    int seq, g, dir, nch, R0;
    if (lat) { dir = it & 1; g = (it >> 1) & 63; seq = it >> 7; nch = 256; R0 = 256 + seq * 256; }
    else { int j = it - 1024; dir = j & 1; g = (j >> 1) & 63; seq = j >> 7; nch = 16; R0 = seq * 16; }
    long li = ((long)(s * 2 + dir) * 64 + g) * 64 + lane;
    float dt = __expf(p.log_dt[(s * 2 + dir) * 64 + g]);
    float mag = __expf(16.f * p.lam_re[li] * dt), sn, cs;
    sincos_red(16.f * p.lam_im[li] * dt, sn, cs);
    const float ar = mag * cs, ai = mag * sn;
    float hr = 0.f, hi = 0.f;
    if (lat) { long si = ((long)((seq * 2 + s) * 2 + dir) * 64 + g) * 64 + lane; hr = p.st_re[si]; hi = p.st_im[si]; }
    const long off = (long)g * NCHR * 256 + dir * 128 + 2 * lane;
    for (int c0 = 0; c0 < nch; c0 += 16) {
      float2 sv[16];
#pragma unroll
      for (int i = 0; i < 16; ++i) {
        int c = dir == 0 ? c0 + i : nch - 1 - (c0 + i);
        unsigned w = __builtin_nontemporal_load(reinterpret_cast<const unsigned*>(S + (long)(R0 + c) * 256 + off));
        sv[i] = make_float2(__uint_as_float(w << 16), __uint_as_float(w & 0xffff0000u));
      }
#pragma unroll
      for (int i = 0; i < 16; ++i) {
        int c = dir == 0 ? c0 + i : nch - 1 - (c0 + i);
        *reinterpret_cast<unsigned*>(Hin + (long)(R0 + c) * 256 + off) = pack2(hr, hi);
        float nr = ar * hr - ai * hi + sv[i].x, ni = ar * hi + ai * hr + sv[i].y;
        hr = nr; hi = ni;
      }
    }
    if (!lat) {
      long oi = ((long)((seq * 2 + s) * 2 + dir) * 64 + g) * 64 + lane;
      p.out[OUT_SR + oi] = hr; p.out[OUT_SI + oi] = hi;
    }
  }
}

#define XB_TMO      128
#define XB_XCNT(j)  (256  + 64 * (j))
#define XB_XSUB(j)  (1280 + 64 * (j))
#define XB_XGEN(j)  (2304 + 64 * (j))
#define XB_TOP      3328
#define XB_TOPGEN   3392
#define XCD_BAR_WORDS 3456
#define XB_SPIN_CAP (1u << 18)
#define LAS __attribute__((address_space(3)))

__device__ __forceinline__ unsigned xb_ld(unsigned* p)              { return __hip_atomic_load(p, __ATOMIC_RELAXED, __HIP_MEMORY_SCOPE_AGENT); }
__device__ __forceinline__ unsigned xb_add(unsigned* p, unsigned v) { return __hip_atomic_fetch_add(p, v, __ATOMIC_RELAXED, __HIP_MEMORY_SCOPE_AGENT); }
__device__ __forceinline__ unsigned xb_xcc_id() { return (unsigned)__builtin_amdgcn_s_getreg((3 << 11) | 20) & 0xFu; }
#define XB_SPIN(cond, bar) do { unsigned _sp = 0; while (cond) { __builtin_amdgcn_s_sleep(1); \
    if ((++_sp & 255u) == 0u) { if (xb_ld(&(bar)[XB_TMO])) break; if (_sp > XB_SPIN_CAP) { atomicAdd(&(bar)[XB_TMO], 1u); break; } } } } while (0)

struct XcdBarrier {
    unsigned* bar; unsigned x;
    volatile LAS unsigned* st;
};

__device__ __forceinline__ XcdBarrier xcd_barrier_post(unsigned* bar, volatile LAS unsigned* st) {
    XcdBarrier b; b.bar = bar; b.x = xb_xcc_id(); b.st = st;
    if (threadIdx.x == 0) (void)xb_add(&bar[XB_XCNT(b.x)], 1u);
    return b;
}
__device__ __forceinline__ void xcd_barrier_complete(unsigned* bar, unsigned x, unsigned& nloc, unsigned& nx) {
    const unsigned G = gridDim.x * gridDim.y * gridDim.z;
    unsigned sum, cnt, mine, sp = 0u;
    for (;;) {
        sum = 0u; cnt = 0u; mine = 0u;
#pragma unroll
        for (unsigned j = 0; j < 16; ++j) { const unsigned c = xb_ld(&bar[XB_XCNT(j)]); sum += c; cnt += (c > 0u) ? 1u : 0u; mine = (j == x) ? c : mine; }
        if (sum == G) break;
        __builtin_amdgcn_s_sleep(1);
        if ((++sp & 255u) == 0u) { if (xb_ld(&bar[XB_TMO])) break; if (sp > XB_SPIN_CAP) { atomicAdd(&bar[XB_TMO], 1u); break; } }
    }
    nloc = mine > 0u ? mine : 1u; nx = cnt > 0u ? cnt : 1u;
}

__device__ __forceinline__ void xcd_barrier(const XcdBarrier& b) {
    asm volatile("s_waitcnt vmcnt(0)" ::: "memory");
    __syncthreads();
    if (threadIdx.x == 0) {
        unsigned* bar = b.bar;
        __builtin_amdgcn_s_waitcnt(0);
        unsigned nloc = b.st[0], nx = b.st[1];
        if (nloc == 0u) { xcd_barrier_complete(bar, b.x, nloc, nx); b.st[0] = nloc; b.st[1] = nx; }
        const unsigned old = xb_add(&bar[XB_XSUB(b.x)], 1u);
        const unsigned gen = old / nloc;
        if (old + 1u == (gen + 1u) * nloc) {
            __builtin_amdgcn_fence(__ATOMIC_RELEASE, "agent");
            asm volatile("s_waitcnt vmcnt(0)" ::: "memory");
            const unsigned og = xb_add(&bar[XB_TOP], 1u);
            const unsigned tg = og / nx;
            if (og + 1u == (tg + 1u) * nx) xb_add(&bar[XB_TOPGEN], 1u);
            else XB_SPIN(xb_ld(&bar[XB_TOPGEN]) == tg, bar);
            __builtin_amdgcn_fence(__ATOMIC_ACQUIRE, "agent");
            xb_add(&bar[XB_XGEN(b.x)], 1u);
            asm volatile("s_waitcnt vmcnt(0)" ::: "memory");
        } else {
            XB_SPIN(xb_ld(&bar[XB_XGEN(b.x)]) == gen, bar);
            __builtin_amdgcn_fence(__ATOMIC_ACQUIRE, "agent");
            asm volatile("s_waitcnt vmcnt(0)" ::: "memory");
        }
    }
    __syncthreads();
}


constexpr int NPHASE = 36;
constexpr int SHM_DYN = SHM_B + 256;

template <int EPI>
DI void gemm_tail_split(const Params& p, GemmArgs g) {
  const int G = gridDim.x, ntiles = g.nM * g.nN, rem = ntiles % G, nfull = ntiles - rem;
  if (rem == 0 || rem * 2 > G || nfull == 0) { gemm_sp2<EPI, 4>(p, g); return; }
  g.tbase = 0; g.sub = 1; g.ucount = nfull;
  gemm_sp2<EPI, 4>(p, g);
  g.tbase = nfull; g.sub = 2; g.ucount = rem * 2;
  gemm_sp2<EPI, 2>(p, g);
}

DI void ffn1(const Params& p, int l) {
  GemmArgs g{}; g.A = (const u16*)(p.ws + OFF_H); g.lda = 1024; g.Bt = (const u16*)(p.ws + OFF_W13); g.K = 1024; g.nM = 144; g.nN = 22;
  g.act = 0; g.ldo = DFF; g.o16 = (u16*)(p.ws + OFF_R1);
  gemm_tail_split<EPI_GATED>(p, g);
}
DI void res_gemm(const Params& p, int l, const u16* A, int lda, const u16* Bt, int K, int gidx) {
  const int lnp = gidx == 5 ? l * 2 : (l == 0 ? -1 : (l - 1) * 2 + 1);
  GemmArgs g{}; g.A = A; g.lda = lda; g.Bt = Bt; g.K = K; g.nM = 192; g.nN = 4; g.layer = l; g.gidx = gidx; g.lnp = lnp; g.o32 = (float*)(p.ws + OFF_X); g.rev = (K == DFF) ? 1 : 0;
  gemm_sp2<EPI_RES, 3>(p, g);
}

DI void run_phase(const Params& pin, int ph) {
  Params p = pin;
  { long z = 0; asm volatile("" : "+s"(z)); p.ws = pin.ws + z; p.out = pin.out + z;
#define OPQ(f) p.f = pin.f + z;
    OPQ(x_prompt) OPQ(x_sample) OPQ(cache_k) OPQ(cache_v) OPQ(st_re) OPQ(st_im) OPQ(c) OPQ(c_ctx) OPQ(w_ada) OPQ(b_ada) OPQ(ln_g) OPQ(ln_b)
    OPQ(w_qkv) OPQ(w_o) OPQ(sink) OPQ(ssm_w_in) OPQ(lam_re) OPQ(lam_im) OPQ(log_dt) OPQ(b_re) OPQ(b_im) OPQ(c_re) OPQ(c_im) OPQ(ssm_d) OPQ(w_glu) OPQ(w_out)
    OPQ(w1) OPQ(w3) OPQ(w2)
#undef OPQ
  }
  if (ph == 0) { prep_phase(p); return; }
  if (ph == 1) { row_phase(p, 0, 0, 0, 0, 0); return; }
  int q = ph - 2, l, sub;
  if (q < 7) { l = 0; sub = q; } else if (q < 17) { l = 1; sub = q - 7; } else if (q < 24) { l = 2; sub = q - 17; } else { l = 3; sub = q - 24; }
  const bool is_attn = (l & 1) == 0;
  int tail = is_attn ? sub - 3 : sub - 6;
  if (tail < 0) {
    if (is_attn) {
      if (sub == 0) {
        GemmArgs g{}; g.A = (const u16*)(p.ws + OFF_H); g.lda = 1024; g.Bt = (const u16*)(p.ws + OFF_WA); g.K = 1024; g.nM = 144; g.nN = 6; g.attn_a = l >> 1;
        gemm_tail_split<EPI_QKV>(p, g);
      } else if (sub == 1) {
        attn_phase(p, l >> 1);
      } else {
        res_gemm(p, l, (const u16*)(p.ws + OFF_R1 + R1_O), 1024, (const u16*)(p.ws + OFF_WB), 1024, 2);
      }
    } else {
      if (sub == 0) {
        GemmArgs g{}; g.A = (const u16*)(p.ws + OFF_H); g.lda = 1024; g.Bt = (const u16*)(p.ws + OFF_WA); g.K = 1024; g.nM = 192; g.nN = 4;
        g.ldo = 1024; g.act = 2; g.o16 = (u16*)(p.ws + OFF_R1 + R1_U);
        gemm_sp2<EPI_PLAIN, 3>(p, g);
      } else if (sub == 1) {
        GemmArgs g{}; g.A = (const u16*)(p.ws + OFF_R1 + R1_U); g.Bt = (const u16*)(p.ws + OFF_PT); g.K = 256; g.nM = 12; g.nN = 1;
        g.o16 = (u16*)(p.ws + OFF_R1 + R1_S);
        gemm_sp2<EPI_S, 3, 1>(p, g);
      } else if (sub == 2) {
        scan_phase(p, l >> 1);
      } else if (sub == 3) {
        GemmArgs g{}; g.A = (const u16*)(p.ws + OFF_R1 + R1_U); g.A2 = (const u16*)(p.ws + OFF_H); g.Bt = (const u16*)(p.ws + OFF_TT); g.K = 512; g.nM = 12; g.nN = 1;
        g.o16 = (u16*)(p.ws + OFF_R1 + R1_G);
        gemm_sp2<EPI_Y, 3, 2>(p, g);
      } else if (sub == 4) {
        GemmArgs g{}; g.A = (const u16*)(p.ws + OFF_R1 + R1_G); g.lda = 1024; g.Bt = (const u16*)(p.ws + OFF_WGLU); g.K = 1024; g.nM = 144; g.nN = 8;
        g.act = 1; g.ldo = 1024; g.o16 = (u16*)(p.ws + OFF_R1 + R1_GL);
        gemm_tail_split<EPI_GATED>(p, g);
      } else {
        res_gemm(p, l, (const u16*)(p.ws + OFF_R1 + R1_GL), 1024, (const u16*)(p.ws + OFF_WB), 1024, 2);
      }
    }
    return;
  }
  if (tail == 0) { row_phase(p, 1, l, 0, l, 3); return; }
  if (tail == 1) { ffn1(p, l); return; }
  if (tail == 2) { res_gemm(p, l, (const u16*)(p.ws + OFF_R1), DFF, (const u16*)(p.ws + OFF_W2), DFF, 5); return; }
  if (l == 3) { row_phase(p, 2, l, 1, 0, 0); return; }
  row_phase(p, 1, l, 1, l + 1, 0);
  __syncthreads();
  conv_layer(p, l + 1);
}

#ifndef PROBE_DUP
#define PROBE_DUP 0
#endif
enum { K_PREP = 0, K_INIT, K_QKV, K_ATTN, K_WO, K_LN, K_FFN1, K_FFN2, K_WIN, K_SSMS, K_SCAN, K_SSMY, K_GLU, K_WOUT };
DI int phase_kind(int ph) {
  if (ph == 0) return K_PREP;
  if (ph == 1) return K_INIT;
  int q = ph - 2, l, sub;
  if (q < 7) { l = 0; sub = q; } else if (q < 17) { l = 1; sub = q - 7; } else if (q < 24) { l = 2; sub = q - 17; } else { l = 3; sub = q - 24; }
  if ((l & 1) == 0) return (int)((0x5765432ULL >> (4 * sub)) & 15);
  return (int)((0x5765DCBA98ULL >> (4 * sub)) & 15);
}

__global__ void __launch_bounds__(512) mk_forward(Params p, int ph_lo, int ph_hi) {
  extern __shared__ __attribute__((aligned(16))) __hip_bfloat16 shm[];
  XcdBarrier xb;
  if (ph_hi - ph_lo > 1) {
    volatile LAS unsigned* st = (volatile LAS unsigned*)((LAS char*)shm + SHM_B);
    if (threadIdx.x == 0) { st[0] = 0u; st[1] = 0u; }
    __syncthreads();
    xb = xcd_barrier_post((unsigned*)(p.ws + OFF_BAR), st);
  }
  for (int ph = ph_lo; ph < ph_hi; ++ph) {
    run_phase(p, ph);
#if PROBE_DUP
    if ((PROBE_DUP >> phase_kind(ph)) & 1) { int reps = phase_kind(ph) == K_INIT ? 4 : 1; for (int r = 0; r < reps; ++r) run_phase(p, ph); }
#endif
    if (ph + 1 < ph_hi) {
      if (ph == ph_lo) cg::this_grid().sync();
      else xcd_barrier(xb);
    }
  }
}

extern "C" void kernel_launch(void* const* d_in, const int* in_sizes, int n_in, void* d_out, int out_size, void* d_ws,
                              size_t ws_size, hipStream_t stream) {
  Params p{};
  const float** f = (const float**)&p;
  for (int i = 0; i < 29; ++i) f[i] = (const float*)d_in[i];
  p.out = (float*)d_out; p.ws = (char*)d_ws;
  static int grid_blocks = 0;
  if (!grid_blocks) {
    hipFuncSetAttribute((const void*)mk_forward, hipFuncAttributeMaxDynamicSharedMemorySize, SHM_DYN);
    int dev = 0, cus = 0, per_cu = 0;
    hipGetDevice(&dev);
    hipDeviceGetAttribute(&cus, hipDeviceAttributeMultiprocessorCount, dev);
    hipOccupancyMaxActiveBlocksPerMultiprocessor(&per_cu, mk_forward, 512, SHM_DYN);
    if (per_cu < 1) per_cu = 1;
    grid_blocks = cus * per_cu;
    if (ws_size < WS_TOTAL) fprintf(stderr, "workspace too small: %zu < %zu\n", ws_size, (size_t)WS_TOTAL);
  }
#if ONE_LAUNCH
  int lo = 0, hi = NPHASE;
  void* args[] = {&p, &lo, &hi};
  hipMemsetAsync((char*)d_ws + OFF_BAR, 0, XCD_BAR_WORDS * sizeof(unsigned), stream);
  hipError_t e = hipLaunchCooperativeKernel((void*)mk_forward, dim3(grid_blocks), dim3(512), args, SHM_DYN, stream);
  if (e != hipSuccess) fprintf(stderr, "cooperative launch failed: %s (grid %d)\n", hipGetErrorString(e), grid_blocks);
#else
  for (int ph = 0; ph < NPHASE; ++ph) mk_forward<<<dim3(grid_blocks), dim3(512), SHM_DYN, stream>>>(p, ph, ph + 1);
#endif
}
```

```cpp
#include <hip/hip_runtime.h>
#include <hip/hip_bf16.h>
#include <hip/hip_cooperative_groups.h>
#include <cstdio>
namespace cg = cooperative_groups;

#ifndef ONE_LAUNCH
#define ONE_LAUNCH 1
#endif

typedef unsigned short u16;
using bf16x8 = __attribute__((ext_vector_type(8))) short;
using f32x4  = __attribute__((ext_vector_type(4))) float;
using f32x16 = __attribute__((ext_vector_type(16))) float;
#define DI __device__ __forceinline__
#define UNR _Pragma("unroll")

constexpr int D = 1024, DFF = 2816, MCTX = 4096, MLAT = 32768, MTOK = 36864;
constexpr int NCHR = 2304;
constexpr float DN_ALPHA = 1.681792830507429f;
constexpr float LN_EPS = 1e-5f;

constexpr long OUT_CK = 37748736L, OUT_CV = 39845888L, OUT_SR = 41943040L, OUT_SI = 42205184L;

constexpr size_t OFF_MODS = 0;
constexpr size_t OFF_ROPE = 1048576;
constexpr size_t OFF_KC   = OFF_ROPE + 65536;
constexpr size_t OFF_VTC  = OFF_KC + 4194304;
constexpr size_t OFF_STATS = OFF_VTC + 4194304;
constexpr size_t OFF_BAR  = OFF_STATS + 524288;
constexpr size_t OFF_X    = OFF_STATS + 1048576;
constexpr size_t OFF_H    = OFF_X + (size_t)MTOK * 4096;
constexpr size_t OFF_WA   = OFF_H + (size_t)MTOK * 2048;
constexpr size_t OFF_WB   = OFF_WA + 4194304;
constexpr size_t OFF_WGLU = OFF_WB + 2097152;
constexpr size_t OFF_W13  = OFF_WGLU + 4194304;
constexpr size_t OFF_W2   = OFF_W13 + 11534336;
constexpr size_t OFF_PT   = OFF_W2 + 5767168;
constexpr size_t OFF_TT   = OFF_PT + 8388608;
constexpr size_t OFF_R1   = OFF_TT + 16777216;
constexpr size_t R1_Q = 0, R1_KB = (size_t)MTOK * 2048, R1_VT = (size_t)MTOK * 2560, R1_O = (size_t)MTOK * 3072;
constexpr size_t R1_U = 0, R1_S = (size_t)MTOK * 2048, R1_G = (size_t)MTOK * 4096, R1_GL = 0;
constexpr size_t WS_TOTAL = OFF_R1 + (size_t)MTOK * 6144;

struct Params {
  const float *x_prompt, *x_sample, *cache_k, *cache_v, *st_re, *st_im, *c, *c_ctx, *w_ada, *b_ada, *ln_g, *ln_b,
      *w_qkv, *w_o, *sink, *ssm_w_in, *lam_re, *lam_im, *log_dt, *b_re, *b_im, *c_re, *c_im, *ssm_d, *w_glu, *w_out,
      *w1, *w3, *w2;
  float* out;
  char* ws;
};

DI int opaque_tid() {
  int w = __builtin_amdgcn_readfirstlane((int)threadIdx.x >> 6);
  int l;
  asm volatile("v_mbcnt_lo_u32_b32 %0, -1, 0\n\tv_mbcnt_hi_u32_b32 %0, -1, %0" : "=v"(l));
  return (w << 6) | l;
}
typedef __bf16 hwbf16x2 __attribute__((ext_vector_type(2)));
typedef float hwf32x2 __attribute__((ext_vector_type(2)));
DI unsigned pack2(float a, float b) { hwf32x2 v = {a, b}; hwbf16x2 r = __builtin_convertvector(v, hwbf16x2); return __builtin_bit_cast(unsigned, r); }
DI u16 f2bf(float f) { return (u16)(pack2(f, 0.f) & 0xffffu); }
DI float bf2f(u16 h) { return __uint_as_float(((unsigned)h) << 16); }
DI float shfl_xor_l(float v, int lane, int mask) { return __int_as_float(__builtin_amdgcn_ds_bpermute((lane ^ mask) << 2, __float_as_int(v))); }
DI float xhalf_max(float v) { auto r = __builtin_amdgcn_permlane32_swap(__float_as_uint(v), __float_as_uint(v), false, false); return fmaxf(__uint_as_float(r[0]), __uint_as_float(r[1])); }
DI float xhalf_sum(float v) { auto r = __builtin_amdgcn_permlane32_swap(__float_as_uint(v), __float_as_uint(v), false, false); return __uint_as_float(r[0]) + __uint_as_float(r[1]); }
DI float wave_sum(float v, int lane) {
#pragma unroll
  for (int o = 32; o > 0; o >>= 1) v += shfl_xor_l(v, lane, o);
  return v;
}
typedef unsigned u32x2v __attribute__((ext_vector_type(2)));
DI float4 nt_load_f4(const float* p) { f32x4 v = __builtin_nontemporal_load(reinterpret_cast<const f32x4*>(p)); return make_float4(v[0], v[1], v[2], v[3]); }
DI uint2 nt_load_u2(const u16* p) { u32x2v v = __builtin_nontemporal_load(reinterpret_cast<const u32x2v*>(p)); return make_uint2(v[0], v[1]); }
typedef unsigned u32x4v __attribute__((ext_vector_type(4)));
DI uint4 nt_load_u4(const void* p) { u32x4v v = __builtin_nontemporal_load(reinterpret_cast<const u32x4v*>(p)); return make_uint4(v[0], v[1], v[2], v[3]); }
DI void nt_store_f4(float* p, float4 x) { f32x4 v = {x.x, x.y, x.z, x.w}; __builtin_nontemporal_store(v, reinterpret_cast<f32x4*>(p)); }
DI int cond_of_row(int row) { return row < MCTX ? 0 : 1 + ((row - MCTX) >> 12); }
DI const float* mods_ptr(const Params& p, int l, int cond, int idx) {
  return (const float*)(p.ws + OFF_MODS) + ((size_t)((l * 9 + cond) * 6 + idx)) * 1024;
}
DI float fast_sigmoid(float x) { return __builtin_amdgcn_rcpf(1.f + __builtin_amdgcn_exp2f(-1.4426950408889634f * x)); }
DI float gelu_tanh(float x) { float u = 0.7978845608028654f * (x + 0.044715f * x * x * x); return x * fast_sigmoid(2.f * u); }

constexpr int BM = 256, BK = 64, HALF = 128, HT = HALF * BK, SHM_B = 8 * HT * 2;

DI int lds_byte(int r, int c) {
  int st = (r >> 4) * 2 + (c >> 5), rr = r & 15, cc = c & 31, ob = rr * 64 + cc * 2;
  return st * 1024 + (ob ^ (((ob >> 9) & 1) << 5));
}
DI void stage_rc(int b, int& R, int& C) {
  int st = b / 1024, sb = b % 1024, swz = sb ^ (((sb >> 9) & 1) << 5);
  R = (st >> 1) * 16 + swz / 64; C = (st & 1) * 32 + (swz % 64) / 2;
}

constexpr bool SPLITK_TAIL = false;
enum { EPI_QKV = 0, EPI_RES = 1, EPI_GATED = 2, EPI_PLAIN = 3, EPI_S = 4, EPI_Y = 5 };

struct GemmArgs {
  const u16* A;
  const u16* A2;
  const u16* Bt;
  int lda, K, nM, nN;
  int layer;
  int gidx;
  int lnp;
  int act;
  int ldo;
  int attn_a;
  int tbase, sub, ucount;
  u16* o16;
  float* o32;
};

template <int EPI, int MT>
DI void gemm_epilogue(const Params& p, const GemmArgs& ga, f32x4 (&acc)[2][2][MT][2], int brow, int bcol, int pn, int grp) {
  constexpr int MROWS = MT * 16, HROWS = 2 * MROWS;
  {
    const int te = opaque_tid();
    const int wid = te >> 6, lane = te & 63, wr = wid >> 2, wc = wid & 3, fr = lane & 15, fq = lane >> 4;
    const int cond = cond_of_row(brow);
    if (EPI == EPI_RES) {
      const float* stats = (const float*)(p.ws + OFF_STATS);
      const float* lg = p.ln_g + (ga.lnp < 0 ? 0 : ga.lnp) * 1024; const float* lb = p.ln_b + (ga.lnp < 0 ? 0 : ga.lnp) * 1024;
      UNR for (int ai = 0; ai < 2; ++ai) UNR for (int m = 0; m < MT; ++m) {
        const int row = brow + ai * HROWS + wr * MROWS + m * 16 + fr;
        const float* gate = mods_ptr(p, ga.layer, cond_of_row(row), ga.gidx);
        float mu = 0.f, rs = 1.f;
        const float* src = row < MCTX ? p.x_prompt + (long)row * D : p.x_sample + (long)(row - MCTX) * D;
        u16* xb = (u16*)ga.o32 + (long)row * D;
        if (ga.lnp >= 0) { float2 st = *reinterpret_cast<const float2*>(stats + (long)row * 2); mu = st.x; rs = st.y; }
        UNR for (int bj = 0; bj < 2; ++bj) {
          const int col0 = bcol + bj * HALF + wc * 32 + fq * 8;
          float xv[8];
          if (ga.lnp >= 0) {
            uint4 raw = nt_load_u4(xb + col0);
            xv[0] = __uint_as_float(raw.x << 16); xv[1] = __uint_as_float(raw.x & 0xffff0000u); xv[2] = __uint_as_float(raw.y << 16); xv[3] = __uint_as_float(raw.y & 0xffff0000u);
            xv[4] = __uint_as_float(raw.z << 16); xv[5] = __uint_as_float(raw.z & 0xffff0000u); xv[6] = __uint_as_float(raw.w << 16); xv[7] = __uint_as_float(raw.w & 0xffff0000u);
          }
          UNR for (int n = 0; n < 2; ++n) {
            const int col = col0 + n * 4;
            float4 g4 = *reinterpret_cast<const float4*>(gate + col);
            f32x4 a = acc[ai][bj][m][n];
            float4 x;
            if (ga.lnp >= 0) {
              float4 w4 = *reinterpret_cast<const float4*>(lg + col), b4 = *reinterpret_cast<const float4*>(lb + col);
              x.x = (xv[n * 4 + 0] - mu) * rs * w4.x + b4.x; x.y = (xv[n * 4 + 1] - mu) * rs * w4.y + b4.y;
              x.z = (xv[n * 4 + 2] - mu) * rs * w4.z + b4.z; x.w = (xv[n * 4 + 3] - mu) * rs * w4.w + b4.w;
            } else x = nt_load_f4(src + col);
            xv[n * 4 + 0] = DN_ALPHA * x.x + g4.x * a[0]; xv[n * 4 + 1] = DN_ALPHA * x.y + g4.y * a[1];
            xv[n * 4 + 2] = DN_ALPHA * x.z + g4.z * a[2]; xv[n * 4 + 3] = DN_ALPHA * x.w + g4.w * a[3];
          }
          uint4 o; o.x = pack2(xv[0], xv[1]); o.y = pack2(xv[2], xv[3]); o.z = pack2(xv[4], xv[5]); o.w = pack2(xv[6], xv[7]);
          *reinterpret_cast<uint4*>(xb + col0) = o;
        }
      }
    } else if (EPI == EPI_GATED) {
      UNR for (int ai = 0; ai < 2; ++ai) UNR for (int m = 0; m < MT; ++m) {
        const int row = brow + ai * HROWS + wr * MROWS + m * 16 + fr, col = pn * HALF + wc * 32 + fq * 8;
        float r[8];
        UNR for (int n = 0; n < 2; ++n) {
          f32x4 a = acc[ai][0][m][n], b = acc[ai][1][m][n];
          UNR for (int j = 0; j < 4; ++j) r[n * 4 + j] = ga.act == 0 ? a[j] * fast_sigmoid(a[j]) * b[j] : a[j] * fast_sigmoid(b[j]);
        }
        uint4 o; o.x = pack2(r[0], r[1]); o.y = pack2(r[2], r[3]); o.z = pack2(r[4], r[5]); o.w = pack2(r[6], r[7]);
        *reinterpret_cast<uint4*>(ga.o16 + (long)row * ga.ldo + col) = o;
      }
    } else if (EPI == EPI_PLAIN) {
      UNR for (int ai = 0; ai < 2; ++ai) UNR for (int bj = 0; bj < 2; ++bj) UNR for (int m = 0; m < MT; ++m) {
        int row = brow + ai * HROWS + wr * MROWS + m * 16 + fr, col = bcol + bj * HALF + wc * 32 + fq * 8;
        f32x4 a0 = acc[ai][bj][m][0], a1 = acc[ai][bj][m][1];
        uint4 o; o.x = pack2(a0[0], a0[1]); o.y = pack2(a0[2], a0[3]); o.z = pack2(a1[0], a1[1]); o.w = pack2(a1[2], a1[3]);
        if (ga.act == 2) *reinterpret_cast<uint4*>(ga.o16 + ((long)(col >> 4) * MTOK + row) * 16 + (col & 15)) = o;
        else *reinterpret_cast<uint4*>(ga.o16 + (long)row * ga.ldo + col) = o;
      }
    } else if (EPI == EPI_S) {
      UNR for (int ai = 0; ai < 2; ++ai) UNR for (int bj = 0; bj < 2; ++bj) UNR for (int m = 0; m < MT; ++m) {
        int R = brow + ai * HROWS + wr * MROWS + m * 16 + fr, col = bj * HALF + wc * 32 + fq * 8;
        f32x4 a0 = acc[ai][bj][m][0], a1 = acc[ai][bj][m][1];
        uint4 o; o.x = pack2(a0[0], a0[1]); o.y = pack2(a0[2], a0[3]); o.z = pack2(a1[0], a1[1]); o.w = pack2(a1[2], a1[3]);
        *reinterpret_cast<uint4*>(ga.o16 + ((long)grp * NCHR + R) * 256 + col) = o;
      }
    } else if (EPI == EPI_Y) {
      UNR for (int ai = 0; ai < 2; ++ai) UNR for (int bj = 0; bj < 2; ++bj) UNR for (int m = 0; m < MT; ++m) {
        int R = brow + ai * HROWS + wr * MROWS + m * 16 + fr, tau = bj * 8 + wc * 2 + (fq >> 1), ch = (fq & 1) * 8;
        f32x4 a0 = acc[ai][bj][m][0], a1 = acc[ai][bj][m][1]; uint4 o;
        o.x = pack2(gelu_tanh(a0[0]), gelu_tanh(a0[1])); o.y = pack2(gelu_tanh(a0[2]), gelu_tanh(a0[3]));
        o.z = pack2(gelu_tanh(a1[0]), gelu_tanh(a1[1])); o.w = pack2(gelu_tanh(a1[2]), gelu_tanh(a1[3]));
        *reinterpret_cast<uint4*>(ga.o16 + ((long)R * 16 + tau) * 1024 + grp * 16 + ch) = o;
      }
    } else {
      u16* Q = (u16*)(p.ws + OFF_R1 + R1_Q); u16* KB = (u16*)(p.ws + OFF_R1 + R1_KB); u16* VT = (u16*)(p.ws + OFF_R1 + R1_VT);
      const float* rope = (const float*)(p.ws + OFF_ROPE);
      const bool is_ctx = brow < MCTX;
      if (pn < 4) {
        UNR for (int ai = 0; ai < 2; ++ai) UNR for (int bj = 0; bj < 2; ++bj) UNR for (int m = 0; m < MT; ++m) {
          int row = brow + ai * HROWS + wr * MROWS + m * 16 + fr, col = bcol + bj * HALF + wc * 32 + fq * 8;
          f32x4 a0 = acc[ai][bj][m][0], a1 = acc[ai][bj][m][1];
          uint4 o; o.x = pack2(a0[0], a0[1]); o.y = pack2(a0[2], a0[3]); o.z = pack2(a1[0], a1[1]); o.w = pack2(a1[2], a1[3]);
          *reinterpret_cast<uint4*>(Q + (long)row * 1024 + col) = o;
        }
      } else if (pn == 4) {
        UNR for (int ai = 0; ai < 2; ++ai) UNR for (int bj = 0; bj < 2; ++bj) UNR for (int m = 0; m < MT; ++m) {
          int row = brow + ai * HROWS + wr * MROWS + m * 16 + fr, c0 = bj * HALF + wc * 32 + fq * 4;
          f32x4 x1 = acc[ai][bj][m][0], x2 = acc[ai][bj][m][1];
          if (is_ctx) {
            int b = row >> 8, t = row & 255;
            float* ck = p.out + OUT_CK + ((long)(b * 2 + ga.attn_a) * 256 + t) * 256;
            *reinterpret_cast<float4*>(ck + c0) = make_float4(x1[0], x1[1], x1[2], x1[3]);
            *reinterpret_cast<float4*>(ck + c0 + 16) = make_float4(x2[0], x2[1], x2[2], x2[3]);
          } else {
            int t = (row - MCTX) & 4095; int pos = (wc & 1) ? (t & 63) : (t >> 6);
            const float* cs = rope + (pos * 16 + fq * 4) * 2;
            float4 cs01 = *reinterpret_cast<const float4*>(cs), cs23 = *reinterpret_cast<const float4*>(cs + 4);
            float cc[4] = {cs01.x, cs01.z, cs23.x, cs23.z}, ss[4] = {cs01.y, cs01.w, cs23.y, cs23.w};
            UNR for (int j = 0; j < 4; ++j) { float a = x1[j], b2 = x2[j]; x1[j] = a * cc[j] - b2 * ss[j]; x2[j] = a * ss[j] + b2 * cc[j]; }
          }
          uint2 o1, o2; o1.x = pack2(x1[0], x1[1]); o1.y = pack2(x1[2], x1[3]); o2.x = pack2(x2[0], x2[1]); o2.y = pack2(x2[2], x2[3]);
          *reinterpret_cast<uint2*>(KB + (long)row * 256 + c0) = o1;
          *reinterpret_cast<uint2*>(KB + (long)row * 256 + c0 + 16) = o2;
        }
      } else {
        UNR for (int ai = 0; ai < 2; ++ai) UNR for (int bj = 0; bj < 2; ++bj) UNR for (int m = 0; m < MT; ++m) UNR for (int n = 0; n < 2; ++n) {
          int row = brow + ai * HROWS + wr * MROWS + m * 16 + fr, c0 = bj * HALF + wc * 32 + n * 16 + fq * 4;
          f32x4 a = acc[ai][bj][m][n];
          if (is_ctx) {
            int b = row >> 8, t = row & 255;
            float* cv = p.out + OUT_CV + ((long)(b * 2 + ga.attn_a) * 256 + t) * 256;
            *reinterpret_cast<float4*>(cv + c0) = make_float4(a[0], a[1], a[2], a[3]);
            u16* vt = VT + ((long)b * 256 + c0) * 256 + t;
            UNR for (int j = 0; j < 4; ++j) vt[j * 256] = f2bf(a[j]);
          } else {
            int b = (row - MCTX) >> 12, t = (row - MCTX) & 4095;
            u16* vt = VT + (long)16 * 256 * 256 + ((long)b * 256 + c0) * 4096 + t;
            UNR for (int j = 0; j < 4; ++j) vt[j * 4096] = f2bf(a[j]);
          }
        }
      }
    }
  }
}

template <int AMODE, int EPI, int MT = 4>
DI void gemm_phase(const Params& p, const GemmArgs& ga) {
  constexpr int MROWS = MT * 16, HROWS = 2 * MROWS, TROWS = 2 * HROWS;
  extern __shared__ __attribute__((aligned(16))) __hip_bfloat16 shm[];
#define SA(b, h) (shm + ((b) * 2 + (h)) * HT)
#define SB(b, h) (shm + (4 + (b) * 2 + (h)) * HT)
#define GLDS(src, dst) __builtin_amdgcn_global_load_lds((const unsigned*)(src), (unsigned*)(dst), 16, 0, 0)
#define STA(P, h, kt) do { const char* _s = (const char*)a_base(h, kt); \
    GLDS(_s + (size_t)offA, (char*)(P) + wsid * 1024); GLDS(_s + skipA + (size_t)offA, (char*)(P) + wsid * 1024 + 8192); } while (0)
#define STB(P, h, kt) do { const char* _s = (const char*)(T.Bb + (long)((h) * HALF) * K + (long)(kt) * BK); \
    GLDS(_s + (size_t)offB, (char*)(P) + wsid * 1024); GLDS(_s + skipB + (size_t)offB, (char*)(P) + wsid * 1024 + 8192); } while (0)
#define LDA(dst, b, h) UNR for (int m = 0; m < MT; ++m) UNR for (int k = 0; k < 2; ++k) \
    dst[m][k] = *reinterpret_cast<const bf16x8*>((char*)SA(b, h) + lds_byte(wr * MROWS + m * 16 + fr, k * 32 + fq * 8))
#define LDB(dst, b, h) UNR for (int n = 0; n < 2; ++n) UNR for (int k = 0; k < 2; ++k) \
    dst[n][k] = *reinterpret_cast<const bf16x8*>((char*)SB(b, h) + lds_byte(wc * 32 + n * 16 + fr, k * 32 + fq * 8))
#define MMA(ai, bj, Af, Bf) do { __builtin_amdgcn_s_setprio(1); \
    UNR for (int m = 0; m < MT; ++m) UNR for (int n = 0; n < 2; ++n) UNR for (int k = 0; k < 2; ++k) \
      acc[ai][bj][m][n] = __builtin_amdgcn_mfma_f32_16x16x32_bf16(Bf[n][k], Af[m][k], acc[ai][bj][m][n], 0, 0, 0); \
    __builtin_amdgcn_s_setprio(0); } while (0)
#define WAIT_V(n) asm volatile("s_waitcnt vmcnt(" #n ")" ::: "memory")
#define WAIT_L(n) asm volatile("s_waitcnt lgkmcnt(" #n ")" ::: "memory")
#define BAR __builtin_amdgcn_s_barrier()
#define SCHED __builtin_amdgcn_sched_barrier(0)

  const int K = ga.K, nM = ga.nM, nN = ga.nN;
  const int ntiles = (AMODE == 0) ? nM * nN : 9 * 64;
  const int tidx = opaque_tid();
  const int wsid = __builtin_amdgcn_readfirstlane((int)threadIdx.x >> 6);
  const int wid = tidx >> 6, lane = tidx & 63, wr = wid >> 2, wc = wid & 3, fr = lane & 15, fq = lane >> 4;
  unsigned offA, offB;
  {
    int R0, C0;
    stage_rc(tidx * 16, R0, C0);
    if (AMODE == 0) offA = (R0 * ga.lda + C0) * 2;
    else offA = (R0 * 256 + C0) * 2;
    offB = (R0 * K + C0) * 2;
  }
  const long skipA = AMODE == 0 ? (long)ga.lda * 128 : 64L * 256 * 2; const long skipB = (long)K * 128;
  const int nt_total = K / BK;
  const int G = gridDim.x;
  int nfull = ntiles, sp = 1;
  if (EPI == EPI_RES) {
    int rem = ntiles % G, pairs = nt_total >> 1;
    if (SPLITK_TAIL && rem) { if (rem * 4 <= G && pairs >= 8) sp = 4; else if (rem * 2 <= G && pairs >= 4) sp = 2; }
    if (sp > 1) nfull = ntiles - rem;
  }
  const int nunits = nfull + (ntiles - nfull) * sp;
  int vb = blockIdx.x;
  if ((G & 7) == 0) vb = (blockIdx.x & 7) * (G >> 3) + (blockIdx.x >> 3);

  struct GTile { int brow, bcol, pn, grp, nt, split; const u16 *Ab, *Ab2, *Bb; };
  auto decode = [&](int u, GTile& T) {
    int tile = u, kt0 = 0; T.nt = nt_total; T.split = 0;
    if (EPI == EPI_RES && u >= nfull) {
      int v = u - nfull, part = v % sp; tile = nfull + v / sp;
      int pairs = nt_total >> 1, qq = pairs / sp, rr = pairs % sp;
      kt0 = 2 * (part * qq + min(part, rr)); T.nt = 2 * (qq + (part < rr ? 1 : 0)); T.split = 1;
    }
    int pm, pn, grp = 0;
    if (AMODE == 0) {
      const int WGM = 8;
      int nig = WGM * nN, gid = tile / nig, fm = gid * WGM, gsz = min(nM - fm, WGM);
      pm = fm + ((tile % nig) % gsz); pn = (tile % nig) / gsz;
    } else { grp = tile / 9; pm = tile % 9; pn = 0; }
    T.brow = pm * TROWS; T.bcol = pn * BM; T.pn = pn; T.grp = grp;
    if (AMODE == 2) T.nt = 4;
    if (AMODE == 0) { T.Ab = ga.A + (long)T.brow * ga.lda + (long)kt0 * BK; T.Ab2 = nullptr; T.Bb = ga.Bt + (long)T.bcol * K + (long)kt0 * BK; }
    else { T.Ab = ga.A + ((long)grp * NCHR + T.brow) * 256; T.Ab2 = ga.A2 + ((long)grp * NCHR + T.brow) * 256; T.Bb = ga.Bt + (long)grp * 256 * K; }
  };
  GTile T, TN;
  auto a_base = [&](int h, int kt) -> const u16* {
    if (AMODE == 0) return T.Ab + (long)(h * HROWS) * ga.lda + (long)kt * BK;
    return T.Ab + (long)(h * HROWS) * 256 + kt * BK;
  };
#define PROLOGUE1() do { STB(SB(0, 0), 0, 0); STA(SA(0, 0), 0, 0); STB(SB(0, 1), 1, 0); STA(SA(0, 1), 1, 0); } while (0)
  int u = vb;
  if (u < nunits) { decode(u, T); PROLOGUE1(); }
  while (u < nunits) {
    const int nt = T.nt;
    f32x4 acc[2][2][MT][2] = {};
    bf16x8 At[MT][2], B0[2][2], B1[2][2];
#pragma unroll 1
    for (int pass = 0; pass < (AMODE == 2 ? 2 : 1); ++pass) {
    if (AMODE == 2 && pass == 1) { T.Ab = T.Ab2; T.Bb += 4 * BK; PROLOGUE1(); }
    if (wr == 1) BAR;
    WAIT_V(4); BAR;
    STB(SB(1, 0), 0, 1); STA(SA(1, 0), 0, 1); STB(SB(1, 1), 1, 1);
    WAIT_V(6); BAR;
    for (int t = 0; t < nt - 2; t += 2) {
      LDB(B0, 0, 0); SCHED; LDA(At, 0, 0); STA(SA(1, 1), 1, t + 1);
      WAIT_L(8); BAR; WAIT_L(0); MMA(0, 0, At, B0); BAR; SCHED;
      LDB(B1, 0, 1); STB(SB(0, 0), 0, t + 2);
      BAR; WAIT_L(0); MMA(0, 1, At, B1); BAR;
      LDA(At, 0, 1); STA(SA(0, 0), 0, t + 2);
      BAR; WAIT_L(0); MMA(1, 0, At, B0); BAR; SCHED;
      STB(SB(0, 1), 1, t + 2);
      WAIT_V(6); BAR; MMA(1, 1, At, B1); BAR;
      LDB(B0, 1, 0); SCHED; LDA(At, 1, 0); STA(SA(0, 1), 1, t + 2);
      WAIT_L(8); BAR; WAIT_L(0); MMA(0, 0, At, B0); BAR; SCHED;
      LDB(B1, 1, 1); STB(SB(1, 0), 0, t + 3);
      BAR; WAIT_L(0); MMA(0, 1, At, B1); BAR;
      LDA(At, 1, 1); STA(SA(1, 0), 0, t + 3);
      BAR; WAIT_L(0); MMA(1, 0, At, B0); BAR; SCHED;
      STB(SB(1, 1), 1, t + 3);
      WAIT_V(6); BAR; MMA(1, 1, At, B1); BAR;
    }
    { LDB(B0, 0, 0); LDA(At, 0, 0); STA(SA(1, 1), 1, nt - 1);
      BAR; WAIT_L(0); MMA(0, 0, At, B0); BAR;
      LDB(B1, 0, 1); BAR; WAIT_L(0); MMA(0, 1, At, B1); BAR;
      LDA(At, 0, 1); WAIT_V(4); BAR; WAIT_L(0); MMA(1, 0, At, B0); MMA(1, 1, At, B1); BAR; }
    { LDB(B0, 1, 0); LDA(At, 1, 0); WAIT_V(2); BAR; WAIT_L(0); MMA(0, 0, At, B0); BAR;
      LDB(B1, 1, 1); WAIT_V(0); BAR; WAIT_L(0); MMA(0, 1, At, B1); BAR;
      LDA(At, 1, 1); BAR; WAIT_L(0); MMA(1, 0, At, B0); MMA(1, 1, At, B1); BAR; }
    if (wr == 0) BAR;
    }
    const int brow = T.brow, bcol = T.bcol, pn = T.pn, grp = T.grp, split = T.split;
    const int un = u + G;
    if (un < nunits) { decode(un, TN); T = TN; PROLOGUE1(); }
    u = un;

    gemm_epilogue<EPI, MT>(p, ga, acc, brow, bcol, pn, grp);
  }
  WAIT_V(0);
#undef SA
#undef SB
}

template <int EPI, int MT, int GMODE = 0>
DI void gemm_sp2(const Params& p, const GemmArgs& ga) {
  constexpr int MROWS = MT * 16, HROWS = 2 * MROWS, TROWS = 2 * HROWS;
  extern __shared__ __attribute__((aligned(16))) __hip_bfloat16 shm[];
#define XSA(b, h) ((char*)shm + ((b) * 2 + (h)) * (HT * 2))
#define XSB(b, h) ((char*)shm + (4 + (b) * 2 + (h)) * (HT * 2))
#define XGL(src, dst) __builtin_amdgcn_global_load_lds((const unsigned*)(src), (unsigned*)(dst), 16, 0, 0)
#define XSTA(P, base) do { const char* _s = (base); XGL(_s + (size_t)offA, (P) + wsid * 1024); XGL(_s + skipA + (size_t)offA, (P) + wsid * 1024 + 8192); } while (0)
#define XSTB(P, base) do { const char* _s = (base); XGL(_s + (size_t)offB, (P) + wsid * 1024); XGL(_s + skipB + (size_t)offB, (P) + wsid * 1024 + 8192); } while (0)
#define XLDA(dst, b, h) UNR for (int m = 0; m < MT; ++m) UNR for (int k = 0; k < 2; ++k) \
    dst[m][k] = *reinterpret_cast<const bf16x8*>(XSA(b, h) + lds_byte(wr * MROWS + m * 16 + fr, k * 32 + fq * 8))
#define XLDB(dst, b, h) UNR for (int n = 0; n < 2; ++n) UNR for (int k = 0; k < 2; ++k) \
    dst[n][k] = *reinterpret_cast<const bf16x8*>(XSB(b, h) + lds_byte(wc * 32 + n * 16 + fr, k * 32 + fq * 8))
#define XMMA(ai, bj, Af, Bf) do { __builtin_amdgcn_s_setprio(1); \
    UNR for (int m = 0; m < MT; ++m) UNR for (int n = 0; n < 2; ++n) UNR for (int k = 0; k < 2; ++k) \
      acc[ai][bj][m][n] = __builtin_amdgcn_mfma_f32_16x16x32_bf16(Bf[n][k], Af[m][k], acc[ai][bj][m][n], 0, 0, 0); \
    __builtin_amdgcn_s_setprio(0); } while (0)
  constexpr int NPASS = GMODE == 2 ? 2 : 1;
  const int K = ga.K, nM = ga.nM, nN = ga.nN, nt = GMODE ? 4 : K / BK, G = gridDim.x;
  const int sub = ga.sub > 0 ? ga.sub : 1;
  const int nunits = GMODE ? 64 * nM : (ga.ucount > 0 ? ga.ucount : nM * nN);
  const int lda = GMODE ? 256 : ga.lda;
  const int tidx = opaque_tid();
  const int wsid = __builtin_amdgcn_readfirstlane((int)threadIdx.x >> 6);
  const int wid = tidx >> 6, lane = tidx & 63, wr = wid >> 2, wc = wid & 3, fr = lane & 15, fq = lane >> 4;
  unsigned offA, offB;
  { int R0, C0; stage_rc(tidx * 16, R0, C0); offA = (R0 * lda + C0) * 2; offB = (R0 * K + C0) * 2; }
  const long skipA = (long)lda * 128, skipB = (long)K * 128;
  const long hstepA = (long)HROWS * lda * 2, hstepB = (long)HALF * K * 2;
  const long kstep = BK * 2;
  int vb = blockIdx.x;
  if ((G & 7) == 0) vb = (blockIdx.x & 7) * (G >> 3) + (blockIdx.x >> 3);
  struct XU { int brow, bcol, pn, grp; const char *cA, *cB; };
  auto decode = [&](int tile, int pass, XU& T) {
    if (GMODE == 0) {
      const int WGM = 8;
      const int part = tile % sub; tile = ga.tbase + tile / sub;
      int nig = WGM * nN, gid = tile / nig, fm = gid * WGM, gsz = min(nM - fm, WGM);
      int pm = fm + ((tile % nig) % gsz), pn = (tile % nig) / gsz;
      T.brow = pm * (TROWS * sub) + part * TROWS; T.bcol = pn * BM; T.pn = pn; T.grp = 0;
      T.cA = (const char*)ga.A + (long)T.brow * lda * 2; T.cB = (const char*)ga.Bt + (long)T.bcol * K * 2;
    } else {
      int grp = tile / nM, pm = tile % nM;
      T.brow = pm * TROWS; T.bcol = 0; T.pn = 0; T.grp = grp;
      T.cA = (const char*)(pass == 0 ? ga.A : ga.A2) + ((long)grp * NCHR + T.brow) * 256 * 2;
      T.cB = (const char*)ga.Bt + ((long)grp * 256 * K + pass * 256) * 2;
    }
  };
  int u = vb, pass = 0;
  if (u >= nunits) return;
  XU cur, nxt;
  decode(u, 0, cur);
  const char* cA = cur.cA; const char* cB = cur.cB;
  f32x4 acc[2][2][MT][2] = {};
  bf16x8 At[MT][2], B0[2][2], B1[2][2];
  XSTB(XSB(0, 0), cB); XSTB(XSB(0, 1), cB + hstepB); XSTA(XSA(0, 0), cA); XSTA(XSA(0, 1), cA + hstepA);
  if (wr == 1) BAR;
  WAIT_V(2); BAR;
  XSTB(XSB(1, 0), cB + kstep); XSTA(XSA(1, 0), cA + kstep); XSTB(XSB(1, 1), cB + hstepB + kstep);
  WAIT_V(6); BAR;
  for (;;) {
    int un = u, npass = pass + 1;
    if (npass == NPASS) { npass = 0; un = u + G; }
    const bool has_next = un < nunits, fin = (pass == NPASS - 1);
    if (has_next) decode(un, npass, nxt);
    const char* nA = has_next ? nxt.cA : cA; const char* nB = has_next ? nxt.cB : cB;
    for (int t = 0; t < nt; t += 2) {
      const bool last = (t == nt - 2);
      const char* a1 = cA + (long)(t + 1) * kstep;
      const char* a2 = last ? nA : cA + (long)(t + 2) * kstep; const char* b2 = last ? nB : cB + (long)(t + 2) * kstep;
      const char* a3 = a2 + kstep; const char* b3 = b2 + kstep;
      XLDB(B0, 0, 0); XLDB(B1, 0, 1); SCHED; XLDA(At, 0, 0); XSTA(XSA(1, 1), a1 + hstepA);
      WAIT_V(8); WAIT_L(0); BAR; XMMA(0, 0, At, B0); XMMA(0, 1, At, B1); BAR; SCHED;
      XLDA(At, 0, 1); XSTB(XSB(0, 0), b2); XSTB(XSB(0, 1), b2 + hstepB); XSTA(XSA(0, 0), a2);
      WAIT_V(8); WAIT_L(0); BAR; XMMA(1, 0, At, B0); XMMA(1, 1, At, B1); BAR; SCHED;
      XLDB(B0, 1, 0); XLDB(B1, 1, 1); SCHED; XLDA(At, 1, 0); XSTA(XSA(0, 1), a2 + hstepA);
      WAIT_V(8); WAIT_L(0); BAR; XMMA(0, 0, At, B0); XMMA(0, 1, At, B1); BAR; SCHED;
      XLDA(At, 1, 1); XSTB(XSB(1, 0), b3); XSTB(XSB(1, 1), b3 + hstepB); XSTA(XSA(1, 0), a3);
      WAIT_V(8); WAIT_L(0); BAR; XMMA(1, 0, At, B0); XMMA(1, 1, At, B1); BAR; SCHED;
    }
    if (fin) {
      if (wr == 0) BAR;
      gemm_epilogue<EPI, MT>(p, ga, acc, cur.brow, cur.bcol, cur.pn, cur.grp);
    }
    if (!has_next) break;
    if (fin) { UNR for (int a = 0; a < 2; ++a) UNR for (int b = 0; b < 2; ++b) UNR for (int m = 0; m < MT; ++m) UNR for (int n = 0; n < 2; ++n) acc[a][b][m][n] = (f32x4){0.f, 0.f, 0.f, 0.f}; }
    cur = nxt; cA = nA; cB = nB; u = un; pass = npass;
    if (fin && wr == 1) BAR;
  }
  WAIT_V(0);
  BAR;
#undef XSA
#undef XSB
}

#define MFMA32(a, b, c) __builtin_amdgcn_mfma_f32_32x32x16_bf16((a), (b), (c), 0, 0, 0)

struct KVTile { bf16x8 k[4]; bf16x8 v[2][2]; };
constexpr int AT_ROW = 144, AT_KB = 64 * AT_ROW, AT_STAGE = 2 * AT_KB;

DI void read_kv(KVTile& t, const char* kbuf, const char* vbuf, int sb, int l32, int h) {
  const int kperm = (l32 & ~12) | ((l32 & 4) << 1) | ((l32 & 8) >> 1);
  const char* kp = kbuf + (sb * 32 + kperm) * AT_ROW + h * 64;
#pragma unroll
  for (int kk = 0; kk < 4; ++kk) t.k[kk] = *reinterpret_cast<const bf16x8*>(kp + kk * 16);
#pragma unroll
  for (int dt = 0; dt < 2; ++dt)
#pragma unroll
    for (int k2 = 0; k2 < 2; ++k2)
      t.v[dt][k2] = *reinterpret_cast<const bf16x8*>(vbuf + (dt * 32 + l32) * AT_ROW + sb * 64 + k2 * 32 + h * 16);
}

template <bool MASK>
DI void attn_tile(const KVTile& t, const bf16x8 (&q)[2][4], f32x16 (&O)[2][2], float (&mrow)[2], float (&lrow)[2],
                  int k0, int q0w, int l32, int h, float c1) {
#pragma unroll
  for (int qt = 0; qt < 2; ++qt) {
    const int q0t = q0w + qt * 32;
    bool need_mask = false;
    if (MASK) {
      if (k0 + 31 < q0t - 128 || k0 > q0t + 31 + 128) continue;
      need_mask = (q0t + 31 - k0 > 128) || (k0 + 31 - q0t > 128);
    }
    f32x16 S;
#pragma unroll
    for (int i = 0; i < 16; ++i) S[i] = 0.f;
#pragma unroll
    for (int kk = 0; kk < 4; ++kk) S = MFMA32(t.k[kk], q[qt][kk], S);
    if (MASK && need_mask) {
      const int base = q0t + l32 - k0 - 8 * h + 128;
#pragma unroll
      for (int r = 0; r < 16; ++r) {
        unsigned d = (unsigned)(base - (16 * (r >> 3) + (r & 7)));
        if (d > 256u) S[r] = -1.0e30f;
      }
    }
    float mx = S[0];
#pragma unroll
    for (int r = 1; r < 16; ++r) mx = fmaxf(mx, S[r]);
    mx = xhalf_max(mx);
    const float mold = mrow[qt];
    const float cand = mx * c1;
    const float mnew = cand > mold + 8.f ? cand : mold;
    mrow[qt] = mnew;
    float rs = 0.f;
#pragma unroll
    for (int r = 0; r < 16; ++r) { float pv = __builtin_amdgcn_exp2f(fmaf(S[r], c1, -mnew)); S[r] = pv; rs += pv; }
    rs = xhalf_sum(rs);
    if (__ballot(mnew != mold) != 0) {
      const float alpha = __builtin_amdgcn_exp2f(mold - mnew);
      lrow[qt] *= alpha;
#pragma unroll
      for (int dt = 0; dt < 2; ++dt)
#pragma unroll
        for (int r = 0; r < 16; ++r) O[qt][dt][r] *= alpha;
    }
    lrow[qt] += rs;
    bf16x8 pk[2];
#pragma unroll
    for (int k2 = 0; k2 < 2; ++k2) {
      uint4 u;
      u.x = pack2(S[8 * k2 + 0], S[8 * k2 + 1]); u.y = pack2(S[8 * k2 + 2], S[8 * k2 + 3]);
      u.z = pack2(S[8 * k2 + 4], S[8 * k2 + 5]); u.w = pack2(S[8 * k2 + 6], S[8 * k2 + 7]);
      pk[k2] = __builtin_bit_cast(bf16x8, u);
    }
#pragma unroll
    for (int dt = 0; dt < 2; ++dt)
#pragma unroll
      for (int k2 = 0; k2 < 2; ++k2) O[qt][dt] = MFMA32(t.v[dt][k2], pk[k2], O[qt][dt]);
  }
}

DI void attn_phase(const Params& p, int a) {
  extern __shared__ __attribute__((aligned(16))) __hip_bfloat16 shm[];
  char* lds = (char*)shm;
  const u16* Q = (const u16*)(p.ws + OFF_R1 + R1_Q); const u16* KB = (const u16*)(p.ws + OFF_R1 + R1_KB);
  const u16* VT = (const u16*)(p.ws + OFF_R1 + R1_VT); u16* Og = (u16*)(p.ws + OFF_R1 + R1_O);
  const u16* KC = (const u16*)(p.ws + OFF_KC); const u16* VTC = (const u16*)(p.ws + OFF_VTC);
  const float* rope = (const float*)(p.ws + OFF_ROPE);
  const int tidx = opaque_tid();
  const int wid = tidx >> 6, lane = tidx & 63, l32 = lane & 31, h = lane >> 5;
  const int grow = tidx >> 3, gc = tidx & 7;
  const float LOG2E = 1.4426950408889634f, c1 = 0.125f * LOG2E;
  for (int it = blockIdx.x; it < 1152; it += gridDim.x) {
    const bool lat = it < 1024;
    int seq, qblk, kvh;
    if (lat) { kvh = it & 3; qblk = (it >> 2) & 31; seq = it >> 7; } else { int j = it - 1024; kvh = j & 3; qblk = (j >> 2) & 1; seq = j >> 3; }
    const int head = kvh * 4 + (wid >> 1);
    const int qb0 = qblk * 128, q0 = qb0 + (wid & 1) * 64;
    const long rowbase = lat ? (long)MCTX + (long)seq * 4096 : (long)seq * 256;
    const u16 *KbA, *VbA; long vsA; int nA;
    if (lat) { KbA = KC + ((long)(seq * 2 + a) * 512) * 256 + kvh * 64; VbA = VTC + ((long)(seq * 2 + a) * 256 + kvh * 64) * 512; vsA = 512; nA = 8; }
    else { KbA = KB + rowbase * 256 + kvh * 64; VbA = VT + ((long)seq * 256 + kvh * 64) * 256; vsA = 256; nA = 4; }
    const u16* KbB = KB + rowbase * 256 + kvh * 64;
    const u16* VbB = VT + (long)16 * 256 * 256 + ((long)seq * 256 + kvh * 64) * 4096;
    const int m0 = qblk == 0 ? 2 : 0, m1 = lat ? (qblk == 31 ? 4 : 6) : 0;
    const int nS = nA + (lat ? m1 - m0 : 0);
    auto issue = [&](int j, uint4& kreg, uint4& vreg) {
      if (j < nA) {
        int key0 = j * 64;
        kreg = *reinterpret_cast<const uint4*>(KbA + (long)(key0 + grow) * 256 + gc * 8);
        vreg = *reinterpret_cast<const uint4*>(VbA + (long)grow * vsA + key0 + gc * 8);
      } else {
        int key0 = qb0 - 128 + (j - nA + m0) * 64;
        kreg = *reinterpret_cast<const uint4*>(KbB + (long)(key0 + grow) * 256 + gc * 8);
        vreg = *reinterpret_cast<const uint4*>(VbB + (long)grow * 4096 + key0 + gc * 8);
      }
    };
    uint4 kreg, vreg;
    issue(0, kreg, vreg);
    bf16x8 q[2][4];
#pragma unroll
    for (int qt = 0; qt < 2; ++qt) {
      const uint4* qp = reinterpret_cast<const uint4*>(Q + (rowbase + q0 + qt * 32 + l32) * 1024 + head * 64 + h * 32);
#pragma unroll
      for (int kk = 0; kk < 4; ++kk) q[qt][kk] = __builtin_bit_cast(bf16x8, qp[kk]);
    }
    const float sk = p.sink[a * 16 + head] * LOG2E;
    float mrow[2] = {sk, sk}, lrow[2] = {1.f, 1.f};
    f32x16 O[2][2];
#pragma unroll
    for (int qt = 0; qt < 2; ++qt)
#pragma unroll
      for (int dt = 0; dt < 2; ++dt)
#pragma unroll
        for (int r = 0; r < 16; ++r) O[qt][dt][r] = 0.f;
    *reinterpret_cast<uint4*>(lds + grow * AT_ROW + gc * 16) = kreg;
    *reinterpret_cast<uint4*>(lds + AT_KB + grow * AT_ROW + gc * 16) = vreg;
    __syncthreads();
#define ATT_STAGE_BEGIN const char* kbuf = lds + (j & 1) * AT_STAGE; const char* vbuf = kbuf + AT_KB; if (j + 1 < nS) issue(j + 1, kreg, vreg);
#define ATT_STAGE_END if (j + 1 < nS) { char* nb = lds + ((j + 1) & 1) * AT_STAGE; \
        *reinterpret_cast<uint4*>(nb + grow * AT_ROW + gc * 16) = kreg; *reinterpret_cast<uint4*>(nb + AT_KB + grow * AT_ROW + gc * 16) = vreg; } \
      __syncthreads();
    for (int j = 0; j < nA; ++j) {
      ATT_STAGE_BEGIN
#pragma unroll 1
      for (int sb = 0; sb < 2; ++sb) {
        KVTile t; read_kv(t, kbuf, vbuf, sb, l32, h);
        attn_tile<false>(t, q, O, mrow, lrow, 0, 0, l32, h, c1);
      }
      ATT_STAGE_END
    }
    if (lat) {
#pragma unroll
      for (int qt = 0; qt < 2; ++qt) {
        int t = q0 + qt * 32 + l32; int pos = h ? (t & 63) : (t >> 6);
#pragma unroll
        for (int kk = 0; kk < 2; ++kk) {
          const float4* cs = reinterpret_cast<const float4*>(rope + (pos * 16 + kk * 8) * 2);
#pragma unroll
          for (int e2 = 0; e2 < 4; ++e2) {
            float4 c4 = cs[e2];
            float cA = c4.x, sA = c4.y, cB = c4.z, sB = c4.w;
            float x1 = bf2f((u16)q[qt][kk][2 * e2]), x2 = bf2f((u16)q[qt][kk + 2][2 * e2]);
            q[qt][kk][2 * e2] = (short)f2bf(x1 * cA - x2 * sA); q[qt][kk + 2][2 * e2] = (short)f2bf(x1 * sA + x2 * cA);
            x1 = bf2f((u16)q[qt][kk][2 * e2 + 1]); x2 = bf2f((u16)q[qt][kk + 2][2 * e2 + 1]);
            q[qt][kk][2 * e2 + 1] = (short)f2bf(x1 * cB - x2 * sB); q[qt][kk + 2][2 * e2 + 1] = (short)f2bf(x1 * sB + x2 * cB);
          }
        }
      }
      for (int j = nA; j < nS; ++j) {
        ATT_STAGE_BEGIN
        const int key0 = qb0 - 128 + (j - nA + m0) * 64;
#pragma unroll 1
        for (int sb = 0; sb < 2; ++sb) {
          const int k0 = key0 + sb * 32;
          if (k0 + 31 >= q0 - 128 && k0 <= q0 + 63 + 128) {
            KVTile t; read_kv(t, kbuf, vbuf, sb, l32, h);
            attn_tile<true>(t, q, O, mrow, lrow, k0, q0, l32, h, c1);
          }
        }
        ATT_STAGE_END
      }
    }
    {
      char* ost = lds + 40960 + wid * (64 * 144);
#pragma unroll
      for (int qt = 0; qt < 2; ++qt) {
        const float inv = __builtin_amdgcn_rcpf(lrow[qt]);
        char* orow = ost + (qt * 32 + l32) * 144 + 8 * h;
#pragma unroll
        for (int dt = 0; dt < 2; ++dt)
#pragma unroll
          for (int g4 = 0; g4 < 4; ++g4) {
            uint2 o; o.x = pack2(O[qt][dt][4 * g4] * inv, O[qt][dt][4 * g4 + 1] * inv);
            o.y = pack2(O[qt][dt][4 * g4 + 2] * inv, O[qt][dt][4 * g4 + 3] * inv);
            *reinterpret_cast<uint2*>(orow + dt * 64 + 16 * g4) = o;
          }
      }
      asm volatile("s_waitcnt lgkmcnt(0)" ::: "memory");
#pragma unroll
      for (int e = 0; e < 8; ++e) {
        const int gidx = lane + 64 * e, r = gidx >> 3, c = gidx & 7;
        uint4 v = *reinterpret_cast<const uint4*>(ost + r * 144 + c * 16);
        *reinterpret_cast<uint4*>(Og + (rowbase + q0 + r) * 1024 + head * 64 + c * 8) = v;
      }
      asm volatile("s_waitcnt lgkmcnt(0)" ::: "memory");
    }
  }
}

DI void row_phase(const Params& p, int mode, int ln_layer, int ln_idx, int mod_layer, int mod_idx) {
  const u16* X = (const u16*)(p.ws + OFF_X); u16* H = (u16*)(p.ws + OFF_H);
  const int tidx = opaque_tid();
  const int lane = tidx & 63, gw = blockIdx.x * 8 + (tidx >> 6), nw = gridDim.x * 8;
  float4 g4[4], b4[4];
  if (mode != 0) {
    const float* g = p.ln_g + (ln_layer * 2 + ln_idx) * 1024; const float* b = p.ln_b + (ln_layer * 2 + ln_idx) * 1024;
    UNR for (int j = 0; j < 4; ++j) { g4[j] = *reinterpret_cast<const float4*>(g + j * 256 + lane * 4); b4[j] = *reinterpret_cast<const float4*>(b + j * 256 + lane * 4); }
  }
  for (int row0 = gw * 2; row0 < MTOK; row0 += nw * 2) {
    float4 v[2][4];
    UNR for (int rr = 0; rr < 2; ++rr) {
      const int row = row0 + rr;
      if (mode == 0) {
        const float* src = row < MCTX ? p.x_prompt + (long)row * D : p.x_sample + (long)(row - MCTX) * D;
        UNR for (int j = 0; j < 4; ++j) v[rr][j] = nt_load_f4(src + j * 256 + lane * 4);
      } else {
        const u16* src = X + (long)row * D;
        UNR for (int j = 0; j < 4; ++j) {
          uint2 raw = nt_load_u2(src + j * 256 + lane * 4);
          v[rr][j] = make_float4(__uint_as_float(raw.x << 16), __uint_as_float(raw.x & 0xffff0000u), __uint_as_float(raw.y << 16), __uint_as_float(raw.y & 0xffff0000u));
        }
      }
    }
    UNR for (int rr = 0; rr < 2; ++rr) {
      const int row = row0 + rr;
      if (mode != 0) {
        float s = 0.f;
        UNR for (int j = 0; j < 4; ++j) s += v[rr][j].x + v[rr][j].y + v[rr][j].z + v[rr][j].w;
        float mu = wave_sum(s, lane) * (1.f / 1024.f);
        float q = 0.f;
        UNR for (int j = 0; j < 4; ++j) { v[rr][j].x -= mu; v[rr][j].y -= mu; v[rr][j].z -= mu; v[rr][j].w -= mu; q += v[rr][j].x * v[rr][j].x + v[rr][j].y * v[rr][j].y + v[rr][j].z * v[rr][j].z + v[rr][j].w * v[rr][j].w; }
        float rstd = rsqrtf(wave_sum(q, lane) * (1.f / 1024.f) + LN_EPS);
        if (mode == 1 && lane == 0) *reinterpret_cast<float2*>((float*)(p.ws + OFF_STATS) + (long)row * 2) = make_float2(mu, rstd);
        UNR for (int j = 0; j < 4; ++j) {
          v[rr][j].x = v[rr][j].x * rstd * g4[j].x + b4[j].x; v[rr][j].y = v[rr][j].y * rstd * g4[j].y + b4[j].y;
          v[rr][j].z = v[rr][j].z * rstd * g4[j].z + b4[j].z; v[rr][j].w = v[rr][j].w * rstd * g4[j].w + b4[j].w;
        }
      }
      if (mode == 2) {
        UNR for (int j = 0; j < 4; ++j) nt_store_f4(p.out + (long)row * D + j * 256 + lane * 4, v[rr][j]);
      } else {
        const int cond = cond_of_row(row);
        const float* sh = mods_ptr(p, mod_layer, cond, mod_idx); const float* sc = mods_ptr(p, mod_layer, cond, mod_idx + 1);
        UNR for (int j = 0; j < 4; ++j) {
          float4 s4 = *reinterpret_cast<const float4*>(sh + j * 256 + lane * 4), c4 = *reinterpret_cast<const float4*>(sc + j * 256 + lane * 4);
          uint2 o; o.x = pack2(v[rr][j].x * (1.f + c4.x) + s4.x, v[rr][j].y * (1.f + c4.y) + s4.y);
          o.y = pack2(v[rr][j].z * (1.f + c4.z) + s4.z, v[rr][j].w * (1.f + c4.w) + s4.w);
          *reinterpret_cast<uint2*>(H + (long)row * D + j * 256 + lane * 4) = o;
        }
      }
    }
  }
}

DI int prow(int n) { int a = n & 31; return (n & ~31) + ((a >> 2) & 1) * 16 + (a >> 3) * 4 + (a & 3); }
DI void sincos_red(float ang, float& s, float& c) {
  float n = rintf(ang * 0.15915494309189535f);
  float r = fmaf(-n, 6.2831854820251465f, ang);
  r = fmaf(-n, -1.7484555e-7f, r);
  s = __sinf(r); c = __cosf(r);
}

DI void ssm_prep(const Params& p, int s) {
  extern __shared__ __attribute__((aligned(16))) __hip_bfloat16 shm[];
  float* L = (float*)shm;
  float* ap_re = L;
  float* ap_im = ap_re + 2176;
  float* bb_re = ap_im + 2176;
  float* bb_im = bb_re + 2048;
  float* cc_re = bb_im + 2048;
  float* cc_im = cc_re + 2048;
  float* kmat = cc_im + 2048;
  u16* Pt = (u16*)(p.ws + OFF_PT); u16* Tt = (u16*)(p.ws + OFF_TT);
  const int tid = opaque_tid();
  for (int it = blockIdx.x; it < 256; it += gridDim.x) {
    const int g = it >> 2, qr = it & 3;
    __syncthreads();
    if (tid < 128) {
      int dir = tid >> 6, pp = tid & 63;
      long li = ((long)(s * 2 + dir) * 64 + g) * 64 + pp;
      float lr = p.lam_re[li], lim = p.lam_im[li];
      float dt = __expf(p.log_dt[(s * 2 + dir) * 64 + g]);
      for (int j = 0; j <= 16; ++j) {
        float mag = __expf((float)j * lr * dt), sn, cs;
        sincos_red((float)j * lim * dt, sn, cs);
        ap_re[(dir * 64 + pp) * 17 + j] = mag * cs; ap_im[(dir * 64 + pp) * 17 + j] = mag * sn;
      }
      float ar = ap_re[(dir * 64 + pp) * 17 + 1], ai = ap_im[(dir * 64 + pp) * 17 + 1];
      float den = lr * lr + lim * lim, nr = ar - 1.f, ni = ai;
      float cr = (nr * lr + ni * lim) / den, ci = (ni * lr - nr * lim) / den;
      for (int m = 0; m < 16; ++m) {
        float br = p.b_re[li * 16 + m], bi = p.b_im[li * 16 + m];
        bb_re[(dir * 64 + pp) * 16 + m] = cr * br - ci * bi; bb_im[(dir * 64 + pp) * 16 + m] = cr * bi + ci * br;
      }
    }
    for (int i = tid; i < 2048; i += 512) {
      int dir = i >> 10, r = i & 1023;
      long ci = ((long)(s * 2 + dir) * 64 + g) * 1024 + r;
      cc_re[i] = p.c_re[ci]; cc_im[i] = p.c_im[ci];
    }
    __syncthreads();
    {
      int dir = tid >> 8, j = (tid >> 4) & 15, m = tid & 15;
      float acc[16];
#pragma unroll
      for (int i = 0; i < 16; ++i) acc[i] = 0.f;
      for (int pp = 0; pp < 64; ++pp) {
        float cr = cc_re[(dir * 16 + m) * 64 + pp], ci = cc_im[(dir * 16 + m) * 64 + pp];
        float ar = ap_re[(dir * 64 + pp) * 17 + j], ai = ap_im[(dir * 64 + pp) * 17 + j];
        float xr = cr * ar - ci * ai, xi = cr * ai + ci * ar;
#pragma unroll
        for (int i = 0; i < 16; ++i) acc[i] += xr * bb_re[(dir * 64 + pp) * 16 + i] - xi * bb_im[(dir * 64 + pp) * 16 + i];
      }
#pragma unroll
      for (int i = 0; i < 16; ++i) kmat[((dir * 16 + j) * 16 + m) * 16 + i] = acc[i];
    }
    __syncthreads();
    for (int gi = tid; gi < 64 * 64; gi += 512) {
      int n = qr * 64 + (gi >> 6), k0 = (gi & 63) * 8, tau = n >> 4, m = n & 15;
      float v[8];
      if (k0 < 256) {
        int sg = k0 >> 4, mp0 = k0 & 15;
#pragma unroll
        for (int e = 0; e < 8; ++e) {
          int mp = mp0 + e; float x = 0.f;
          if (sg <= tau) x += kmat[((0 * 16 + (tau - sg)) * 16 + m) * 16 + mp];
          if (sg >= tau) x += kmat[((1 * 16 + (sg - tau)) * 16 + m) * 16 + mp];
          if (sg == tau && mp == m) x += p.ssm_d[s * 1024 + g * 16 + m];
          v[e] = x;
        }
      } else {
        int qq = k0 - 256, dir = qq >> 7, p0 = (qq & 127) >> 1;
        int ex = dir == 0 ? tau + 1 : 16 - tau;
#pragma unroll
        for (int e2 = 0; e2 < 4; ++e2) {
          int pp = p0 + e2;
          float cr = cc_re[(dir * 16 + m) * 64 + pp], ci = cc_im[(dir * 16 + m) * 64 + pp];
          float ar = ap_re[(dir * 64 + pp) * 17 + ex], ai = ap_im[(dir * 64 + pp) * 17 + ex];
          v[2 * e2] = cr * ar - ci * ai; v[2 * e2 + 1] = -(cr * ai + ci * ar);
        }
      }
      uint4 o; o.x = pack2(v[0], v[1]); o.y = pack2(v[2], v[3]); o.z = pack2(v[4], v[5]); o.w = pack2(v[6], v[7]);
      *reinterpret_cast<uint4*>(Tt + ((long)g * 256 + prow(n)) * 512 + k0) = o;
    }
    for (int gi = tid; gi < 64 * 32; gi += 512) {
      int n = qr * 64 + (gi >> 5), k0 = (gi & 31) * 8, dir = n >> 7, pp = (n & 127) >> 1, ri = n & 1;
      int sg = k0 >> 4, mp0 = k0 & 15, ex = dir == 0 ? 15 - sg : sg;
      float ar = ap_re[(dir * 64 + pp) * 17 + ex], ai = ap_im[(dir * 64 + pp) * 17 + ex];
      float v[8];
#pragma unroll
      for (int e = 0; e < 8; ++e) {
        float br = bb_re[(dir * 64 + pp) * 16 + mp0 + e], bi = bb_im[(dir * 64 + pp) * 16 + mp0 + e];
        v[e] = ri ? (ar * bi + ai * br) : (ar * br - ai * bi);
      }
      uint4 o; o.x = pack2(v[0], v[1]); o.y = pack2(v[2], v[3]); o.z = pack2(v[4], v[5]); o.w = pack2(v[6], v[7]);
      *reinterpret_cast<uint4*>(Pt + ((long)g * 256 + prow(n)) * 256 + k0) = o;
    }
  }
  __syncthreads();
}

struct ConvDesc { const float* src; u16* dst; int ld, K, N, mode, tstart, tend; };
DI void conv_table(const Params& p, int l, ConvDesc* tab, int* cnt, int zz) {
  char* ws = p.ws;
  const int a = l >> 1;
  int n = 0, ts = zz;
  auto add = [&](const float* src, u16* dst, int ld, int K, int N, int mode) {
    ConvDesc d; d.src = src; d.dst = dst; d.ld = ld + zz; d.K = K + zz; d.N = N + zz; d.mode = mode + zz; d.tstart = ts; ts += (K >> 6) * (N >> 6); d.tend = ts;
    tab[n++] = d;
  };
  if ((l & 1) == 0) {
    add(p.w_qkv + (long)a * 1024 * 1536, (u16*)(ws + OFF_WA), 1536, 1024, 1536, 3);
    add(p.w_o + (long)a * 1024 * 1024, (u16*)(ws + OFF_WB), 1024, 1024, 1024, 0);
  } else {
    add(p.ssm_w_in + (long)a * 1024 * 1024, (u16*)(ws + OFF_WA), 1024, 1024, 1024, 0);
    add(p.w_out + (long)a * 1024 * 1024, (u16*)(ws + OFF_WB), 1024, 1024, 1024, 0);
    add(p.w_glu + (long)a * 1024 * 2048, (u16*)(ws + OFF_WGLU), 2048, 1024, 1024, 1);
    add(p.w_glu + (long)a * 1024 * 2048 + 1024, (u16*)(ws + OFF_WGLU), 2048, 1024, 1024, 2);
  }
  add(p.w1 + (long)l * 1024 * DFF, (u16*)(ws + OFF_W13), DFF, 1024, DFF, 1);
  add(p.w3 + (long)l * 1024 * DFF, (u16*)(ws + OFF_W13), DFF, 1024, DFF, 2);
  add(p.w2 + (long)l * DFF * 1024, (u16*)(ws + OFF_W2), 1024, DFF, 1024, 0);
  *cnt = n;
}

DI void conv_layer(const Params& p, int l) {
  extern __shared__ __attribute__((aligned(16))) __hip_bfloat16 shm[];
  float* lds = (float*)shm;
  ConvDesc* tab = (ConvDesc*)((char*)shm + 4 * 64 * 65 * 4);
  int* cntp = (int*)((char*)shm + 4 * 64 * 65 * 4 + 8 * sizeof(ConvDesc));
  const int tidc = opaque_tid();
  int nb = gridDim.x, bid = blockIdx.x;
  __syncthreads();
  int zz = 0; asm volatile("" : "+s"(zz));
  if (tidc == 0) conv_table(p, l, tab, cntp, zz);
  __syncthreads();
  const int cnt = *cntp, total = tab[cnt - 1].tend;
  auto find = [&](int gt) -> int { int i = 0; while (i < cnt - 1 && gt >= tab[i].tend) ++i; return i; };
  auto issue = [&](int gt, float (&r)[8]) {
    const int i = find(gt);
    const float* src = tab[i].src; const int ld = tab[i].ld, tnn = tab[i].N >> 6, t = gt - tab[i].tstart, kt = t / tnn, nt = t % tnn;
    UNR for (int e = 0; e < 8; ++e) { int idx = tidc + 512 * e, kk = idx >> 6, nn = idx & 63; r[e] = __builtin_nontemporal_load(src + (long)(kt * 64 + kk) * ld + nt * 64 + nn); }
  };
  auto emit = [&](int gt, const float* L) {
    const int i = find(gt);
    u16* dst = tab[i].dst; const int K = tab[i].K, mode = tab[i].mode, tnn = tab[i].N >> 6, t = gt - tab[i].tstart, kt = t / tnn, nt = t % tnn;
    int n = tidc >> 3, k8 = (tidc & 7) * 8, ng = nt * 64 + n;
    const int a32 = ng & 31, pa = ((a32 >> 2) & 1) * 16 + (a32 >> 3) * 4 + (a32 & 3);
    int nr = (mode == 1 || mode == 2) ? ((ng >> 7) * 256 + (mode == 2 ? 128 : 0) + (ng & 96) + pa)
                                      : ((mode == 0 || ng < 1024) ? (ng & ~31) + pa : ng);
    uint4 o;
    o.x = pack2(L[(k8 + 0) * 65 + n], L[(k8 + 1) * 65 + n]); o.y = pack2(L[(k8 + 2) * 65 + n], L[(k8 + 3) * 65 + n]);
    o.z = pack2(L[(k8 + 4) * 65 + n], L[(k8 + 5) * 65 + n]); o.w = pack2(L[(k8 + 6) * 65 + n], L[(k8 + 7) * 65 + n]);
    *reinterpret_cast<uint4*>(dst + (long)nr * K + kt * 64 + k8) = o;
  };
  float r0[8], r1[8];
  int gt = 2 * bid, buf = 0;
  if (gt < total) issue(gt, r0);
  if (gt + 1 < total) issue(gt + 1, r1);
  for (; gt < total; gt += 2 * nb) {
    float* L0 = lds + buf * (2 * 64 * 65); float* L1 = L0 + 64 * 65;
    const bool two = gt + 1 < total;
    UNR for (int e = 0; e < 8; ++e) { int idx = tidc + 512 * e, kk = idx >> 6, nn = idx & 63; L0[kk * 65 + nn] = r0[e]; if (two) L1[kk * 65 + nn] = r1[e]; }
    if (gt + 2 * nb < total) issue(gt + 2 * nb, r0);
    if (gt + 2 * nb + 1 < total) issue(gt + 2 * nb + 1, r1);
    __syncthreads();
    emit(gt, L0);
    if (two) emit(gt + 1, L1);
    buf ^= 1;
  }
  if (l & 1) { __syncthreads(); ssm_prep(p, l >> 1); }
}

DI void prep_phase(const Params& p) {
  extern __shared__ __attribute__((aligned(16))) __hip_bfloat16 shm[];
  float* L = (float*)shm;
  const int tid = opaque_tid();
  for (int it = blockIdx.x; it < 192; it += gridDim.x) {
    float* sc = L;
    float* red = L + 9216;
    __syncthreads();
    for (int i = tid; i < 9216; i += 512) {
      int cd = i >> 10, k = i & 1023;
      float v = cd == 0 ? p.c_ctx[k] : p.c[(cd - 1) * 1024 + k];
      sc[i] = v * fast_sigmoid(v);
    }
    __syncthreads();
    const int cg4 = tid & 31, ks = tid >> 5;
    const int cidx = it * 128 + cg4 * 4, l = cidx / 6144, col = cidx % 6144;
    const float* w = p.w_ada + ((long)l * 1024 + ks * 64) * 6144 + col;
    float acc[9][4];
#pragma unroll
    for (int i = 0; i < 9; ++i) { acc[i][0] = 0.f; acc[i][1] = 0.f; acc[i][2] = 0.f; acc[i][3] = 0.f; }
#pragma unroll 8
    for (int k = 0; k < 64; ++k) {
      float4 wv = nt_load_f4(w + (long)k * 6144);
#pragma unroll
      for (int i = 0; i < 9; ++i) { float sv = sc[i * 1024 + ks * 64 + k]; acc[i][0] += sv * wv.x; acc[i][1] += sv * wv.y; acc[i][2] += sv * wv.z; acc[i][3] += sv * wv.w; }
    }
#pragma unroll
    for (int i = 0; i < 9; ++i) *reinterpret_cast<float4*>(red + (ks * 9 + i) * 128 + cg4 * 4) = make_float4(acc[i][0], acc[i][1], acc[i][2], acc[i][3]);
    __syncthreads();
    if (tid < 128) {
      const int c1 = it * 128 + tid, l1 = c1 / 6144, col1 = c1 % 6144;
      float bia = p.b_ada[l1 * 6144 + col1];
      float* mo = (float*)(p.ws + OFF_MODS);
#pragma unroll
      for (int i = 0; i < 9; ++i) {
        float v = bia;
#pragma unroll
        for (int k2 = 0; k2 < 16; ++k2) v += red[(k2 * 9 + i) * 128 + tid];
        mo[((long)(l1 * 9 + i)) * 6144 + col1] = v;
      }
    }
    __syncthreads();
  }
  if (blockIdx.x == gridDim.x - 1) {
    float* rope = (float*)(p.ws + OFF_ROPE);
    for (int i = tid; i < 1024; i += 512) {
      int pos = i >> 4, f = i & 15;
      float inv = exp2f(-(float)f * (13.287712379549449f / 16.f));
      float sn, cs; sincos_red((float)pos * inv, sn, cs);
      rope[i * 2] = cs; rope[i * 2 + 1] = sn;
    }
  }
  {
    u16* KC = (u16*)(p.ws + OFF_KC); u16* VTC = (u16*)(p.ws + OFF_VTC);
    const long nthr = (long)gridDim.x * 512, gt = (long)blockIdx.x * 512 + tid;
    for (long i = gt; i < 2097152 / 4; i += nthr) {
      float4 v = nt_load_f4(p.cache_k + i * 4);
      uint2 o; o.x = pack2(v.x, v.y); o.y = pack2(v.z, v.w);
      *reinterpret_cast<uint2*>(KC + i * 4) = o;
    }
    for (long i = gt; i < 16L * 64 * 256; i += nthr) {
      int col = (int)(i & 255), kg = (int)((i >> 8) & 63), ba = (int)(i >> 14);
      const float* src = p.cache_v + ((long)ba * 512 + kg * 8) * 256 + col;
      float v[8];
#pragma unroll
      for (int e = 0; e < 8; ++e) v[e] = __builtin_nontemporal_load(src + e * 256);
      uint4 o; o.x = pack2(v[0], v[1]); o.y = pack2(v[2], v[3]); o.z = pack2(v[4], v[5]); o.w = pack2(v[6], v[7]);
      *reinterpret_cast<uint4*>(VTC + ((long)ba * 256 + col) * 512 + kg * 8) = o;
    }
  }
  __syncthreads();
  conv_layer(p, 0);
}

DI void scan_phase(const Params& p, int s) {
  const u16* S = (const u16*)(p.ws + OFF_R1 + R1_S);
  u16* Hin = (u16*)(p.ws + OFF_H);
  const int tidx = opaque_tid();
  const int lane = tidx & 63, gw = blockIdx.x * 8 + (tidx >> 6), nw = gridDim.x * 8;
  for (int it = gw; it < 3072; it += nw) {
    const bool lat = it < 1024;
    int seq, g, dir, nch, R0;
    if (lat) { dir = it & 1; g = (it >> 1) & 63; seq = it >> 7; nch = 256; R0 = 256 + seq * 256; }
    else { int j = it - 1024; dir = j & 1; g = (j >> 1) & 63; seq = j >> 7; nch = 16; R0 = seq * 16; }
    long li = ((long)(s * 2 + dir) * 64 + g) * 64 + lane;
    float dt = __expf(p.log_dt[(s * 2 + dir) * 64 + g]);
    float mag = __expf(16.f * p.lam_re[li] * dt), sn, cs;
    sincos_red(16.f * p.lam_im[li] * dt, sn, cs);
    const float ar = mag * cs, ai = mag * sn;
    float hr = 0.f, hi = 0.f;
    if (lat) { long si = ((long)((seq * 2 + s) * 2 + dir) * 64 + g) * 64 + lane; hr = p.st_re[si]; hi = p.st_im[si]; }
    const long off = (long)g * NCHR * 256 + dir * 128 + 2 * lane;
    for (int c0 = 0; c0 < nch; c0 += 16) {
      float2 sv[16];
#pragma unroll
      for (int i = 0; i < 16; ++i) {
        int c = dir == 0 ? c0 + i : nch - 1 - (c0 + i);
        unsigned w = __builtin_nontemporal_load(reinterpret_cast<const unsigned*>(S + (long)(R0 + c) * 256 + off));
        sv[i] = make_float2(__uint_as_float(w << 16), __uint_as_float(w & 0xffff0000u));
      }
#pragma unroll
      for (int i = 0; i < 16; ++i) {
        int c = dir == 0 ? c0 + i : nch - 1 - (c0 + i);
        *reinterpret_cast<unsigned*>(Hin + (long)(R0 + c) * 256 + off) = pack2(hr, hi);
        float nr = ar * hr - ai * hi + sv[i].x, ni = ar * hi + ai * hr + sv[i].y;
        hr = nr; hi = ni;
      }
    }
    if (!lat) {
      long oi = ((long)((seq * 2 + s) * 2 + dir) * 64 + g) * 64 + lane;
      p.out[OUT_SR + oi] = hr; p.out[OUT_SI + oi] = hi;
    }
  }
}

#define XB_TMO      128
#define XB_XCNT(j)  (256  + 64 * (j))
#define XB_XSUB(j)  (1280 + 64 * (j))
#define XB_XGEN(j)  (2304 + 64 * (j))
#define XB_TOP      3328
#define XB_TOPGEN   3392
#define XCD_BAR_WORDS 3456
#define XB_SPIN_CAP (1u << 18)
#define LAS __attribute__((address_space(3)))

__device__ __forceinline__ unsigned xb_ld(unsigned* p)              { return __hip_atomic_load(p, __ATOMIC_RELAXED, __HIP_MEMORY_SCOPE_AGENT); }
__device__ __forceinline__ unsigned xb_add(unsigned* p, unsigned v) { return __hip_atomic_fetch_add(p, v, __ATOMIC_RELAXED, __HIP_MEMORY_SCOPE_AGENT); }
__device__ __forceinline__ unsigned xb_xcc_id() { return (unsigned)__builtin_amdgcn_s_getreg((3 << 11) | 20) & 0xFu; }
#define XB_SPIN(cond, bar) do { unsigned _sp = 0; while (cond) { __builtin_amdgcn_s_sleep(1); \
    if ((++_sp & 255u) == 0u) { if (xb_ld(&(bar)[XB_TMO])) break; if (_sp > XB_SPIN_CAP) { atomicAdd(&(bar)[XB_TMO], 1u); break; } } } } while (0)

struct XcdBarrier {
    unsigned* bar; unsigned x;
    volatile LAS unsigned* st;
};

__device__ __forceinline__ XcdBarrier xcd_barrier_post(unsigned* bar, volatile LAS unsigned* st) {
    XcdBarrier b; b.bar = bar; b.x = xb_xcc_id(); b.st = st;
    if (threadIdx.x == 0) (void)xb_add(&bar[XB_XCNT(b.x)], 1u);
    return b;
}
__device__ __forceinline__ void xcd_barrier_complete(unsigned* bar, unsigned x, unsigned& nloc, unsigned& nx) {
    const unsigned G = gridDim.x * gridDim.y * gridDim.z;
    unsigned sum, cnt, mine, sp = 0u;
    for (;;) {
        sum = 0u; cnt = 0u; mine = 0u;
#pragma unroll
        for (unsigned j = 0; j < 16; ++j) { const unsigned c = xb_ld(&bar[XB_XCNT(j)]); sum += c; cnt += (c > 0u) ? 1u : 0u; mine = (j == x) ? c : mine; }
        if (sum == G) break;
        __builtin_amdgcn_s_sleep(1);
        if ((++sp & 255u) == 0u) { if (xb_ld(&bar[XB_TMO])) break; if (sp > XB_SPIN_CAP) { atomicAdd(&bar[XB_TMO], 1u); break; } }
    }
    nloc = mine > 0u ? mine : 1u; nx = cnt > 0u ? cnt : 1u;
}

__device__ __forceinline__ void xcd_barrier(const XcdBarrier& b) {
    asm volatile("s_waitcnt vmcnt(0)" ::: "memory");
    __syncthreads();
    if (threadIdx.x == 0) {
        unsigned* bar = b.bar;
        __builtin_amdgcn_s_waitcnt(0);
        unsigned nloc = b.st[0], nx = b.st[1];
        if (nloc == 0u) { xcd_barrier_complete(bar, b.x, nloc, nx); b.st[0] = nloc; b.st[1] = nx; }
        const unsigned old = xb_add(&bar[XB_XSUB(b.x)], 1u);
        const unsigned gen = old / nloc;
        if (old + 1u == (gen + 1u) * nloc) {
            __builtin_amdgcn_fence(__ATOMIC_RELEASE, "agent");
            asm volatile("s_waitcnt vmcnt(0)" ::: "memory");
            const unsigned og = xb_add(&bar[XB_TOP], 1u);
            const unsigned tg = og / nx;
            if (og + 1u == (tg + 1u) * nx) xb_add(&bar[XB_TOPGEN], 1u);
            else XB_SPIN(xb_ld(&bar[XB_TOPGEN]) == tg, bar);
            __builtin_amdgcn_fence(__ATOMIC_ACQUIRE, "agent");
            xb_add(&bar[XB_XGEN(b.x)], 1u);
            asm volatile("s_waitcnt vmcnt(0)" ::: "memory");
        } else {
            XB_SPIN(xb_ld(&bar[XB_XGEN(b.x)]) == gen, bar);
            __builtin_amdgcn_fence(__ATOMIC_ACQUIRE, "agent");
            asm volatile("s_waitcnt vmcnt(0)" ::: "memory");
        }
    }
    __syncthreads();
}


constexpr int NPHASE = 36;
constexpr int SHM_DYN = SHM_B + 256;

template <int EPI>
DI void gemm_tail_split(const Params& p, GemmArgs g) {
  const int G = gridDim.x, ntiles = g.nM * g.nN, rem = ntiles % G, nfull = ntiles - rem;
  if (rem == 0 || rem * 2 > G || nfull == 0) { gemm_sp2<EPI, 4>(p, g); return; }
  g.tbase = 0; g.sub = 1; g.ucount = nfull;
  gemm_sp2<EPI, 4>(p, g);
  g.tbase = nfull; g.sub = 2; g.ucount = rem * 2;
  gemm_sp2<EPI, 2>(p, g);
}

DI void ffn1(const Params& p, int l) {
  GemmArgs g{}; g.A = (const u16*)(p.ws + OFF_H); g.lda = 1024; g.Bt = (const u16*)(p.ws + OFF_W13); g.K = 1024; g.nM = 144; g.nN = 22;
  g.act = 0; g.ldo = DFF; g.o16 = (u16*)(p.ws + OFF_R1);
  gemm_tail_split<EPI_GATED>(p, g);
}
DI void res_gemm(const Params& p, int l, const u16* A, int lda, const u16* Bt, int K, int gidx) {
  const int lnp = gidx == 5 ? l * 2 : (l == 0 ? -1 : (l - 1) * 2 + 1);
  GemmArgs g{}; g.A = A; g.lda = lda; g.Bt = Bt; g.K = K; g.nM = 192; g.nN = 4; g.layer = l; g.gidx = gidx; g.lnp = lnp; g.o32 = (float*)(p.ws + OFF_X);
  gemm_sp2<EPI_RES, 3>(p, g);
}

DI void run_phase(const Params& pin, int ph) {
  Params p = pin;
  { long z = 0; asm volatile("" : "+s"(z)); p.ws = pin.ws + z; p.out = pin.out + z;
#define OPQ(f) p.f = pin.f + z;
    OPQ(x_prompt) OPQ(x_sample) OPQ(cache_k) OPQ(cache_v) OPQ(st_re) OPQ(st_im) OPQ(c) OPQ(c_ctx) OPQ(w_ada) OPQ(b_ada) OPQ(ln_g) OPQ(ln_b)
    OPQ(w_qkv) OPQ(w_o) OPQ(sink) OPQ(ssm_w_in) OPQ(lam_re) OPQ(lam_im) OPQ(log_dt) OPQ(b_re) OPQ(b_im) OPQ(c_re) OPQ(c_im) OPQ(ssm_d) OPQ(w_glu) OPQ(w_out)
    OPQ(w1) OPQ(w3) OPQ(w2)
#undef OPQ
  }
  if (ph == 0) { prep_phase(p); return; }
  if (ph == 1) { row_phase(p, 0, 0, 0, 0, 0); return; }
  int q = ph - 2, l, sub;
  if (q < 7) { l = 0; sub = q; } else if (q < 17) { l = 1; sub = q - 7; } else if (q < 24) { l = 2; sub = q - 17; } else { l = 3; sub = q - 24; }
  const bool is_attn = (l & 1) == 0;
  int tail = is_attn ? sub - 3 : sub - 6;
  if (tail < 0) {
    if (is_attn) {
      if (sub == 0) {
        GemmArgs g{}; g.A = (const u16*)(p.ws + OFF_H); g.lda = 1024; g.Bt = (const u16*)(p.ws + OFF_WA); g.K = 1024; g.nM = 144; g.nN = 6; g.attn_a = l >> 1;
        gemm_tail_split<EPI_QKV>(p, g);
      } else if (sub == 1) {
        attn_phase(p, l >> 1);
      } else {
        res_gemm(p, l, (const u16*)(p.ws + OFF_R1 + R1_O), 1024, (const u16*)(p.ws + OFF_WB), 1024, 2);
      }
    } else {
      if (sub == 0) {
        GemmArgs g{}; g.A = (const u16*)(p.ws + OFF_H); g.lda = 1024; g.Bt = (const u16*)(p.ws + OFF_WA); g.K = 1024; g.nM = 192; g.nN = 4;
        g.ldo = 1024; g.act = 2; g.o16 = (u16*)(p.ws + OFF_R1 + R1_U);
        gemm_sp2<EPI_PLAIN, 3>(p, g);
      } else if (sub == 1) {
        GemmArgs g{}; g.A = (const u16*)(p.ws + OFF_R1 + R1_U); g.Bt = (const u16*)(p.ws + OFF_PT); g.K = 256; g.nM = 12; g.nN = 1;
        g.o16 = (u16*)(p.ws + OFF_R1 + R1_S);
        gemm_sp2<EPI_S, 3, 1>(p, g);
      } else if (sub == 2) {
        scan_phase(p, l >> 1);
      } else if (sub == 3) {
        GemmArgs g{}; g.A = (const u16*)(p.ws + OFF_R1 + R1_U); g.A2 = (const u16*)(p.ws + OFF_H); g.Bt = (const u16*)(p.ws + OFF_TT); g.K = 512; g.nM = 12; g.nN = 1;
        g.o16 = (u16*)(p.ws + OFF_R1 + R1_G);
        gemm_sp2<EPI_Y, 3, 2>(p, g);
      } else if (sub == 4) {
        GemmArgs g{}; g.A = (const u16*)(p.ws + OFF_R1 + R1_G); g.lda = 1024; g.Bt = (const u16*)(p.ws + OFF_WGLU); g.K = 1024; g.nM = 144; g.nN = 8;
        g.act = 1; g.ldo = 1024; g.o16 = (u16*)(p.ws + OFF_R1 + R1_GL);
        gemm_tail_split<EPI_GATED>(p, g);
      } else {
        res_gemm(p, l, (const u16*)(p.ws + OFF_R1 + R1_GL), 1024, (const u16*)(p.ws + OFF_WB), 1024, 2);
      }
    }
    return;
  }
  if (tail == 0) { row_phase(p, 1, l, 0, l, 3); return; }
  if (tail == 1) { ffn1(p, l); return; }
  if (tail == 2) { res_gemm(p, l, (const u16*)(p.ws + OFF_R1), DFF, (const u16*)(p.ws + OFF_W2), DFF, 5); return; }
  if (l == 3) { row_phase(p, 2, l, 1, 0, 0); return; }
  row_phase(p, 1, l, 1, l + 1, 0);
  __syncthreads();
  conv_layer(p, l + 1);
}

#ifndef PROBE_DUP
#define PROBE_DUP 0
#endif
enum { K_PREP = 0, K_INIT, K_QKV, K_ATTN, K_WO, K_LN, K_FFN1, K_FFN2, K_WIN, K_SSMS, K_SCAN, K_SSMY, K_GLU, K_WOUT };
DI int phase_kind(int ph) {
  if (ph == 0) return K_PREP;
  if (ph == 1) return K_INIT;
  int q = ph - 2, l, sub;
  if (q < 7) { l = 0; sub = q; } else if (q < 17) { l = 1; sub = q - 7; } else if (q < 24) { l = 2; sub = q - 17; } else { l = 3; sub = q - 24; }
  if ((l & 1) == 0) return (int)((0x5765432ULL >> (4 * sub)) & 15);
  return (int)((0x5765DCBA98ULL >> (4 * sub)) & 15);
}

__global__ void __launch_bounds__(512) mk_forward(Params p, int ph_lo, int ph_hi) {
  extern __shared__ __attribute__((aligned(16))) __hip_bfloat16 shm[];
  XcdBarrier xb;
  if (ph_hi - ph_lo > 1) {
    volatile LAS unsigned* st = (volatile LAS unsigned*)((LAS char*)shm + SHM_B);
    if (threadIdx.x == 0) { st[0] = 0u; st[1] = 0u; }
    __syncthreads();
    xb = xcd_barrier_post((unsigned*)(p.ws + OFF_BAR), st);
  }
  for (int ph = ph_lo; ph < ph_hi; ++ph) {
    run_phase(p, ph);
#if PROBE_DUP
    if ((PROBE_DUP >> phase_kind(ph)) & 1) { int reps = phase_kind(ph) == K_INIT ? 4 : 1; for (int r = 0; r < reps; ++r) run_phase(p, ph); }
#endif
    if (ph + 1 < ph_hi) {
      if (ph == ph_lo) cg::this_grid().sync();
      else xcd_barrier(xb);
    }
  }
}

extern "C" void kernel_launch(void* const* d_in, const int* in_sizes, int n_in, void* d_out, int out_size, void* d_ws,
                              size_t ws_size, hipStream_t stream) {
  Params p{};
  const float** f = (const float**)&p;
  for (int i = 0; i < 29; ++i) f[i] = (const float*)d_in[i];
  p.out = (float*)d_out; p.ws = (char*)d_ws;
  static int grid_blocks = 0;
  if (!grid_blocks) {
    hipFuncSetAttribute((const void*)mk_forward, hipFuncAttributeMaxDynamicSharedMemorySize, SHM_DYN);
    int dev = 0, cus = 0, per_cu = 0;
    hipGetDevice(&dev);
    hipDeviceGetAttribute(&cus, hipDeviceAttributeMultiprocessorCount, dev);
    hipOccupancyMaxActiveBlocksPerMultiprocessor(&per_cu, mk_forward, 512, SHM_DYN);
    if (per_cu < 1) per_cu = 1;
    grid_blocks = cus * per_cu;
    if (ws_size < WS_TOTAL) fprintf(stderr, "workspace too small: %zu < %zu\n", ws_size, (size_t)WS_TOTAL);
  }
#if ONE_LAUNCH
  int lo = 0, hi = NPHASE;
  void* args[] = {&p, &lo, &hi};
  hipMemsetAsync((char*)d_ws + OFF_BAR, 0, XCD_BAR_WORDS * sizeof(unsigned), stream);
  hipError_t e = hipLaunchCooperativeKernel((void*)mk_forward, dim3(grid_blocks), dim3(512), args, SHM_DYN, stream);
  if (e != hipSuccess) fprintf(stderr, "cooperative launch failed: %s (grid %d)\n", hipGetErrorString(e), grid_blocks);
#else
  for (int ph = 0; ph < NPHASE; ++ph) mk_forward<<<dim3(grid_blocks), dim3(512), SHM_DYN, stream>>>(p, ph, ph + 1);
#endif
}
```
